# Optimizing an MI355X kernel written in HIP

```python
import math
import functools
import jax
import jax.numpy as jnp
from jax import lax
import numpy as np

D_MODEL = 1024
BATCH = 4
SEQ = 4096
DEPTH = 1
DEC_BATCH = 32
DEC_SEQ = 1
PAST_LEN = 8192
PAGE_SIZE = 128

H_A = 8
DH_A = 64
W_A = H_A * DH_A
H_IDX = 8
DH_IDX = 64
TOPK_MAX = 256
Q_BLOCK = 128
NUM_BUCKETS = 32
MAX_DISTANCE = 128
H_R = 4
DK_R = 128
DV_R = 128
W_R = H_R * DV_R
RET_CHUNK = 128
ROPE_BASE = 10000.0
MIX_WIDTH = W_A + W_R
D_FF = 2816
ALPHA = (2 * DEPTH) ** 0.25
BETA = (8 * DEPTH) ** -0.25
LN_EPS = 1e-5
GN_EPS = 1e-5
IN_SIZES = (W_A, W_A, W_A, H_IDX * DH_IDX, DH_IDX, H_IDX, H_R * DK_R, H_R * DK_R, W_R, W_R)
N_IN = 3 * W_A + H_IDX * DH_IDX + DH_IDX + H_IDX + 2 * H_R * DK_R + 2 * W_R

kernel_name = "hymba_dsa_retnet_macaron_deepnorm_step"


def _split_points():
    pts, acc = [], 0
    for s in IN_SIZES[:-1]:
        acc += s
        pts.append(acc)
    return pts


def layer_norm(x, g, b):
    xf = x.astype(jnp.float32)
    mu = xf.mean(-1, keepdims=True)
    var = jnp.square(xf - mu).mean(-1, keepdims=True)
    return ((xf - mu) * lax.rsqrt(var + LN_EPS)).astype(x.dtype) * g + b


def swiglu(x, wg, wu, wd):
    return (jax.nn.silu(x @ wg) * (x @ wu)) @ wd


def rotary(x, pos):
    half = x.shape[-1] // 2
    freqs = ROPE_BASE ** (-jnp.arange(half, dtype=jnp.float32) / half)
    ang = pos.astype(jnp.float32)[:, None] * freqs[None, :]
    cos = jnp.cos(ang)[None, :, None, :]
    sin = jnp.sin(ang)[None, :, None, :]
    xf = x.astype(jnp.float32)
    x1, x2 = xf[..., :half], xf[..., half:]
    return jnp.concatenate([x1 * cos - x2 * sin, x1 * sin + x2 * cos], axis=-1)


def t5_bucket(rel):
    n = jnp.maximum(rel, 0)
    max_exact = NUM_BUCKETS // 2
    nf = jnp.maximum(n, 1).astype(jnp.float32)
    large = max_exact + (jnp.log(nf / max_exact) / math.log(MAX_DISTANCE / max_exact)
                         * (NUM_BUCKETS - max_exact)).astype(jnp.int32)
    large = jnp.minimum(large, NUM_BUCKETS - 1)
    return jnp.where(n < max_exact, n, large)


def take_rows(arr, idx):
    return jax.vmap(lambda a, i: a[i])(arr, idx)


def indexer_scores(qi, ki, wi, qpos, kpos):
    dots = jnp.einsum('bqhd,bld->bqhl', qi, ki).astype(jnp.float32) * DH_IDX ** -0.5
    s = jnp.einsum('bqh,bqhl->bql', wi.astype(jnp.float32) * H_IDX ** -0.5, jax.nn.relu(dots))
    return jnp.where(kpos[None, None, :] <= qpos[None, :, None], s, -jnp.inf)


def sparse_attend(q, qpos, scores, topk, gather_kv, rel_bias):
    _, idx = lax.top_k(scores, topk)
    valid = idx <= qpos[None, :, None]
    k_sel, v_sel = gather_kv(idx)
    logits = jnp.einsum('bqhd,bqkhd->bhqk', q, k_sel).astype(jnp.float32) * DH_A ** -0.5
    bias = rel_bias[t5_bucket(qpos[None, :, None] - idx)].astype(jnp.float32)
    logits = logits + bias.transpose(0, 3, 1, 2)
    logits = jnp.where(valid[:, None], logits, -jnp.inf)
    p = jax.nn.softmax(logits, axis=-1)
    return jnp.einsum('bhqk,bqkhd->bqhd', p.astype(v_sel.dtype), v_sel).astype(q.dtype)


def prompt_attention(q, k, v, qi, ki, wi, rel_bias):
    B, S = q.shape[:2]
    topk = min(TOPK_MAX, S // 4)
    kpos = jnp.arange(S, dtype=jnp.int32)

    def gather_kv(idx):
        return take_rows(k, idx), take_rows(v, idx)

    def block(start):
        qb = lax.dynamic_slice_in_dim(q, start, Q_BLOCK, axis=1)
        qib = lax.dynamic_slice_in_dim(qi, start, Q_BLOCK, axis=1)
        wib = lax.dynamic_slice_in_dim(wi, start, Q_BLOCK, axis=1)
        qpos = start + jnp.arange(Q_BLOCK, dtype=jnp.int32)
        scores = indexer_scores(qib, ki, wib, qpos, kpos)
        return sparse_attend(qb, qpos, scores, topk, gather_kv, rel_bias)

    out = lax.map(block, jnp.arange(0, S, Q_BLOCK, dtype=jnp.int32))
    return out.transpose(1, 0, 2, 3, 4).reshape(B, S, H_A, DH_A)


def sample_attention(q, k_new, v_new, qi, ki_new, wi, rel_bias, cache_k, cache_v, cache_kidx, page_table, layer):
    DB, DS = q.shape[:2]
    n_pages = page_table.shape[1]
    past = n_pages * PAGE_SIZE
    L = past + DS
    topk = min(TOPK_MAX, L // 4)
    qpos = past + jnp.arange(DS, dtype=jnp.int32)
    kpos = jnp.arange(L, dtype=jnp.int32)
    ki_past = cache_kidx[layer, page_table].reshape(DB, past, DH_IDX)
    ki_all = jnp.concatenate([ki_past.astype(ki_new.dtype), ki_new], axis=1)
    scores = indexer_scores(qi, ki_all, wi, qpos, kpos)

    def gather_kv(idx):
        is_new = (idx >= past)[..., None, None]
        page = take_rows(page_table, jnp.minimum(idx // PAGE_SIZE, n_pages - 1))
        off = idx % PAGE_SIZE
        new_i = jnp.clip(idx - past, 0, DS - 1)
        k_sel = jnp.where(is_new, take_rows(k_new, new_i), cache_k[layer, page, off].astype(k_new.dtype))
        v_sel = jnp.where(is_new, take_rows(v_new, new_i), cache_v[layer, page, off].astype(v_new.dtype))
        return k_sel, v_sel

    return sparse_attend(q, qpos, scores, topk, gather_kv, rel_bias)


def retention(q, k, v, s0):
    B, S = q.shape[:2]
    C = RET_CHUNK if S % RET_CHUNK == 0 else S
    nc = S // C
    lg = jnp.log1p(-jnp.exp2(-5.0 - jnp.arange(H_R, dtype=jnp.float32)))
    i = jnp.arange(C, dtype=jnp.float32)
    diff = i[:, None] - i[None, :]
    causal = diff >= 0
    intra = jnp.where(causal[None], jnp.exp(jnp.where(causal, diff, 0.0)[None] * lg[:, None, None]), 0.0)
    cross_decay = jnp.exp((i[:, None] + 1.0) * lg[None, :])
    kv_decay = jnp.exp((C - 1.0 - i)[:, None] * lg[None, :])
    chunk_decay = jnp.exp(C * lg)

    def to_chunks(a):
        return a.reshape(B, nc, C, H_R, a.shape[-1]).transpose(1, 0, 2, 3, 4)

    def step(s, inp):
        qc, kc, vc = inp
        att = jnp.einsum('bihd,bjhd->bhij', qc, kc) * intra[None]
        o = (jnp.einsum('bhij,bjhv->bihv', att, vc)
             + jnp.einsum('bihd,bhdv->bihv', qc, s) * cross_decay[None, :, :, None])
        s_new = chunk_decay[None, :, None, None] * s + jnp.einsum('bjhd,jh,bjhv->bhdv', kc, kv_decay, vc)
        return s_new, o

    s_fin, o = lax.scan(step, s0, (to_chunks(q), to_chunks(k), to_chunks(v)))
    return o.transpose(1, 0, 2, 3, 4).reshape(B, S, H_R, DV_R), s_fin


def decoder_layer(x, pos, attend, s0, ffn1_wg, ffn1_wu, ffn1_wd, ln1_g, ln1_b, w_in, ret_gn_g, w_out,
                  ln2_g, ln2_b, ffn2_wg, ffn2_wu, ffn2_wd, ln3_g, ln3_b):
    B, S, _ = x.shape
    h = layer_norm(ALPHA * x + 0.5 * swiglu(x, ffn1_wg, ffn1_wu, ffn1_wd), ln1_g, ln1_b)
    q_a, k_a, v_a, q_i, k_i, w_i, q_r, k_r, v_r, g_r = jnp.split(h @ w_in, _split_points(), axis=-1)
    q_a = q_a.reshape(B, S, H_A, DH_A)
    k_a = k_a.reshape(B, S, H_A, DH_A)
    v_a = v_a.reshape(B, S, H_A, DH_A)
    q_i = q_i.reshape(B, S, H_IDX, DH_IDX)
    o_a = attend(q_a, k_a, v_a, q_i, k_i, w_i)
    qr = rotary(q_r.reshape(B, S, H_R, DK_R), pos)
    kr = rotary(k_r.reshape(B, S, H_R, DK_R), pos) * DK_R ** -0.5
    vr = v_r.reshape(B, S, H_R, DV_R).astype(jnp.float32)
    o_r, s_new = retention(qr, kr, vr, s0.astype(jnp.float32))
    mu = o_r.mean(-1, keepdims=True)
    var = jnp.square(o_r - mu).mean(-1, keepdims=True)
    y_r = ((o_r - mu) * lax.rsqrt(var + GN_EPS)).reshape(B, S, W_R).astype(x.dtype) * ret_gn_g
    y_r = jax.nn.silu(g_r) * y_r
    mix = jnp.concatenate([o_a.reshape(B, S, W_A), y_r], axis=-1) @ w_out
    h = layer_norm(ALPHA * h + mix, ln2_g, ln2_b)
    h = layer_norm(ALPHA * h + 0.5 * swiglu(h, ffn2_wg, ffn2_wu, ffn2_wd), ln3_g, ln3_b)
    return h, k_a, v_a, k_i, s_new


def setup_inputs(seed: int = 0) -> dict:
    key = jax.random.key(seed)
    ks = jax.random.split(key, 32)
    f32 = jnp.float32
    nrm = lambda k, shp, sc: jax.random.normal(k, shp, f32) * sc
    n_pages = PAST_LEN // PAGE_SIZE
    n_used = DEC_BATCH * n_pages
    n_pool = n_used + n_used // 4
    perm = jax.random.permutation(ks[0], n_pool)
    page_table = perm[:n_used].reshape(DEC_BATCH, n_pages).astype(jnp.int32)

    w_in = nrm(ks[8], (DEPTH, D_MODEL, N_IN), D_MODEL ** -0.5)
    w_in = w_in.at[..., 2 * W_A:3 * W_A].multiply(BETA).at[..., N_IN - 2 * W_R:N_IN - W_R].multiply(BETA)

    return {
        "x_prompt": nrm(ks[1], (BATCH, SEQ, D_MODEL), 1.0),
        "x_sample": nrm(ks[2], (DEC_BATCH, DEC_SEQ, D_MODEL), 1.0),
        "cache_k": nrm(ks[3], (DEPTH, n_pool, PAGE_SIZE, H_A, DH_A), 1.0),
        "cache_v": nrm(ks[4], (DEPTH, n_pool, PAGE_SIZE, H_A, DH_A), BETA),
        "cache_kidx": nrm(ks[5], (DEPTH, n_pool, PAGE_SIZE, DH_IDX), 1.0),
        "state_ret": nrm(ks[6], (DEPTH, DEC_BATCH, H_R, DK_R, DV_R), 0.5),
        "page_table": page_table,
        "rel_bias": nrm(ks[7], (NUM_BUCKETS, H_A), 0.5),
        "ffn1_wg": nrm(ks[9], (DEPTH, D_MODEL, D_FF), D_MODEL ** -0.5),
        "ffn1_wu": nrm(ks[10], (DEPTH, D_MODEL, D_FF), D_MODEL ** -0.5),
        "ffn1_wd": nrm(ks[11], (DEPTH, D_FF, D_MODEL), BETA * D_FF ** -0.5),
        "ln1_g": 1.0 + nrm(ks[12], (DEPTH, D_MODEL), 0.05),
        "ln1_b": nrm(ks[13], (DEPTH, D_MODEL), 0.02),
        "w_in": w_in,
        "ret_gn_g": 1.0 + nrm(ks[14], (DEPTH, W_R), 0.05),
        "w_out": nrm(ks[15], (DEPTH, MIX_WIDTH, D_MODEL), BETA * MIX_WIDTH ** -0.5),
        "ln2_g": 1.0 + nrm(ks[16], (DEPTH, D_MODEL), 0.05),
        "ln2_b": nrm(ks[17], (DEPTH, D_MODEL), 0.02),
        "ffn2_wg": nrm(ks[18], (DEPTH, D_MODEL, D_FF), D_MODEL ** -0.5),
        "ffn2_wu": nrm(ks[19], (DEPTH, D_MODEL, D_FF), D_MODEL ** -0.5),
        "ffn2_wd": nrm(ks[20], (DEPTH, D_FF, D_MODEL), BETA * D_FF ** -0.5),
        "ln3_g": 1.0 + nrm(ks[21], (DEPTH, D_MODEL), 0.05),
        "ln3_b": nrm(ks[22], (DEPTH, D_MODEL), 0.02),
    }


def reference(x_prompt, x_sample, cache_k, cache_v, cache_kidx, state_ret, page_table, rel_bias,
              ffn1_wg, ffn1_wu, ffn1_wd, ln1_g, ln1_b, w_in, ret_gn_g, w_out,
              ln2_g, ln2_b, ffn2_wg, ffn2_wu, ffn2_wd, ln3_g, ln3_b):
    B, S, _ = x_prompt.shape
    DB, DS, _ = x_sample.shape
    past = page_table.shape[1] * PAGE_SIZE
    pos_p = jnp.arange(S, dtype=jnp.int32)
    pos_s = past + jnp.arange(DS, dtype=jnp.int32)
    s0_p = jnp.zeros((B, H_R, DK_R, DV_R), jnp.float32)
    attend_p = functools.partial(prompt_attention, rel_bias=rel_bias)

    hp, hs = x_prompt, x_sample
    kp_l, vp_l, kip_l, sp_l = [], [], [], []
    ks_l, vs_l, kis_l, ss_l = [], [], [], []
    for l in range(DEPTH):
        lw = (ffn1_wg[l], ffn1_wu[l], ffn1_wd[l], ln1_g[l], ln1_b[l], w_in[l], ret_gn_g[l], w_out[l],
              ln2_g[l], ln2_b[l], ffn2_wg[l], ffn2_wu[l], ffn2_wd[l], ln3_g[l], ln3_b[l])
        attend_s = functools.partial(sample_attention, rel_bias=rel_bias, cache_k=cache_k, cache_v=cache_v,
                                     cache_kidx=cache_kidx, page_table=page_table, layer=l)
        hp, kp, vp, kip, sp = decoder_layer(hp, pos_p, attend_p, s0_p, *lw)
        hs, ksn, vsn, kisn, ssn = decoder_layer(hs, pos_s, attend_s, state_ret[l], *lw)
        kp_l.append(kp); vp_l.append(vp); kip_l.append(kip); sp_l.append(sp)
        ks_l.append(ksn); vs_l.append(vsn); kis_l.append(kisn); ss_l.append(ssn)

    k_prompt = jnp.stack(kp_l)
    v_prompt = jnp.stack(vp_l)
    kidx_prompt = jnp.stack(kip_l)
    ret_state_prompt = jnp.stack(sp_l)
    k_sample = jnp.stack(ks_l)
    v_sample = jnp.stack(vs_l)
    kidx_sample = jnp.stack(kis_l)
    ret_state_sample = jnp.stack(ss_l)
    return (hp, hs, k_prompt, v_prompt, kidx_prompt, ret_state_prompt,
            k_sample, v_sample, kidx_sample, ret_state_sample)
```

```cpp
#include <hip/hip_runtime.h>
#include <cstdio>
#include <cstdint>

#define LAS __attribute__((address_space(3)))
#define GAS __attribute__((address_space(1)))
typedef unsigned short h16;
typedef short s16x8 __attribute__((ext_vector_type(8)));
typedef _Float16 f16x8 __attribute__((ext_vector_type(8)));
typedef _Float16 f16x2 __attribute__((ext_vector_type(2)));
typedef float f32x2 __attribute__((ext_vector_type(2)));
typedef float f32x4 __attribute__((ext_vector_type(4)));
typedef unsigned u32x4 __attribute__((ext_vector_type(4)));
typedef unsigned u32x2 __attribute__((ext_vector_type(2)));
typedef GAS unsigned gu32;

constexpr int DM = 1024, NB = 4, SEQ = 4096, MP = NB * SEQ, NS = 32, MR = MP + 256, MV = MP + NS, DFF = 2816;
constexpr int WA = 512, WRT = 512, HA = 8, DHA = 64, HR = 4, DKR = 128;
constexpr int NIN = 4168, NINP = 4352;
constexpr int PAST = 8192, PAGE = 128, NPAGES = 64, LS = PAST + 1, TOPK = 256;
constexpr float ALPHA = 1.189207115002721f;
constexpr float LN_EPS = 1e-5f, GN_EPS = 1e-5f;
constexpr int C_QA = 0, C_KA = 512, C_VA = 1024, C_QI = 1536, C_KI = 2048, C_WI = 2112, C_QR = 2120, C_KR = 2632, C_VR = 3144, C_GR = 3656;
constexpr size_t O_Y = 0, O_YS = (size_t)MP * DM, O_KP = O_YS + (size_t)NS * DM, O_VP = O_KP + (size_t)MP * WA, O_KIP = O_VP + (size_t)MP * WA,
                 O_RSP = O_KIP + (size_t)MP * 64, O_KS = O_RSP + (size_t)NB * HR * 128 * 128, O_VS = O_KS + (size_t)NS * WA, O_KIS = O_VS + (size_t)NS * WA,
                 O_RSS = O_KIS + (size_t)NS * 64, O_END = O_RSS + (size_t)NS * HR * 128 * 128;
static_assert(O_END == 37029888, "d_out size");

constexpr size_t MiB = 1u << 20;
constexpr size_t al(size_t x) { return (x + MiB - 1) / MiB * MiB; }
constexpr size_t WS_CTL = 0, CTL_ZERO_BYTES = 1 * MiB;
constexpr size_t WS_WGU1 = 2 * MiB;
constexpr size_t WS_WD1 = WS_WGU1 + al((size_t)2 * DFF * DM * 2);
constexpr size_t WS_WIN = WS_WD1 + al((size_t)DM * DFF * 2);
constexpr size_t WS_WOUT = WS_WIN + al((size_t)NINP * DM * 2);
constexpr size_t WS_WGU2 = WS_WOUT + al((size_t)DM * DM * 2);
constexpr size_t WS_WD2 = WS_WGU2 + al((size_t)2 * DFF * DM * 2);
constexpr size_t WS_ROT = WS_WD2 + al((size_t)DM * DFF * 2);
constexpr size_t WS_X16 = WS_ROT + al((size_t)4097 * 64 * 8);
constexpr size_t WS_H1 = WS_X16 + al((size_t)MR * DM * 2);
constexpr size_t WS_V = WS_H1 + al((size_t)MR * DFF * 2);
constexpr size_t WS_HF = WS_V + al((size_t)MR * DM * 4);
constexpr size_t WS_H16 = WS_HF + al((size_t)MR * DM * 4);
constexpr size_t SZ_P16 = al((size_t)MR * 512 * 2);
constexpr size_t WS_QA = WS_H16 + al((size_t)MR * DM * 2);
constexpr size_t WS_KA = WS_QA + SZ_P16, WS_VA = WS_KA + SZ_P16, WS_QI = WS_VA + SZ_P16, WS_QR = WS_QI + SZ_P16, WS_KR = WS_QR + SZ_P16, WS_VR = WS_KR + SZ_P16, WS_GR = WS_VR + SZ_P16;
constexpr size_t WS_KI = WS_GR + SZ_P16;
constexpr size_t WS_WI = WS_KI + al((size_t)MR * 64 * 2);
constexpr size_t WS_MIX = WS_WI + al((size_t)MR * 8 * 4);
constexpr size_t WS_KVC = WS_MIX + al((size_t)MR * DM * 2);
constexpr size_t WS_SC = WS_KVC + al((size_t)NB * HR * 32 * 16384 * 4);
constexpr size_t WS_END = WS_SC + al((size_t)NB * HR * 32 * 16384 * 4);

constexpr int CW_TMO = 0, CW_CODE = 1, CW_BAR = 4096;

constexpr int RING_BYTES = 131072;
constexpr int LDSCTL_OFF = RING_BYTES, MISC_OFF = LDSCTL_OFF + 320;
constexpr int LDS_BYTES = 147456;
constexpr int NWAVES = 8, NTHR = 512;

__device__ __forceinline__ unsigned pkh(float a, float b) { f32x2 v = {a, b}; f16x2 h = __builtin_convertvector(v, f16x2); return __builtin_bit_cast(unsigned, h); }
__device__ __forceinline__ h16 f2h(float a) { _Float16 h = (_Float16)a; return __builtin_bit_cast(h16, h); }
__device__ __forceinline__ float h2f(h16 a) { return (float)__builtin_bit_cast(_Float16, a); }
__device__ __forceinline__ float hlo(unsigned w) { return h2f((h16)(w & 0xffffu)); }
__device__ __forceinline__ float hhi(unsigned w) { return h2f((h16)(w >> 16)); }
#define LDS_WAIT() asm volatile("s_waitcnt lgkmcnt(0)" ::: "memory")
#define VM_WAIT() asm volatile("s_waitcnt vmcnt(0)" ::: "memory")
__device__ __forceinline__ float wave_sum(float v) {
#pragma unroll
    for (int o = 1; o < 64; o <<= 1) v += __shfl_xor(v, o);
    return v;
}
__device__ __forceinline__ float wave_max(float v) {
#pragma unroll
    for (int o = 1; o < 64; o <<= 1) v = fmaxf(v, __shfl_xor(v, o));
    return v;
}
__device__ __forceinline__ float silu_f(float g) { return g * __builtin_amdgcn_rcpf(1.0f + __builtin_amdgcn_exp2f(-1.4426950408889634f * g)); }

namespace pg8 {
constexpr int BM = 256, BK = 64, HALF = 128, HTB = HALF * BK * 2, STAGE_BYTES = 8 * HTB, NXCD = 8, WGM = 8;
__host__ __device__ __forceinline__ int lds_byte(int r, int c) { const int st = (r >> 4) * 2 + (c >> 5), rr = r & 15, cc = c & 31, ob = rr * 64 + cc * 2; return st * 1024 + (ob ^ (((ob >> 9) & 1) << 5)); }
__host__ __device__ __forceinline__ void stage_rc(int b, int& R, int& C) { const int st = b / 1024, sb = b % 1024, swz = sb ^ (((sb >> 9) & 1) << 5); R = (st >> 1) * 16 + swz / 64; C = (st & 1) * 32 + (swz % 64) / 2; }
__host__ __device__ __forceinline__ int perm32(int rho) { const int n = rho >> 4, i = rho & 15; return 8 * (i >> 2) + 4 * n + (i & 3); }
struct Unit { int pm, pn; };
struct Gemm { const h16* A; const h16* Bt; int M, N, K; };
struct StaticOrder {
    int nM, nN, nwg, G, c;
    __host__ __device__ void init(int M, int N, int G_, int c_) { nM = M / BM; nN = N / BM; nwg = nM * nN; G = G_; c = c_; }
    __host__ __device__ bool next(int i, Unit& u) const {
        const long L = (long)i * G + c; if (L >= nwg) return false;
        int wgid = (int)L; { const int q = nwg / NXCD, r = nwg % NXCD, xcd = wgid % NXCD, off = wgid / NXCD; wgid = (xcd < r ? xcd * (q + 1) : r * (q + 1) + (xcd - r) * q) + off; }
        const int nig = WGM * nN, gid = wgid / nig, fm = gid * WGM, gsz = (nM - fm) < WGM ? (nM - fm) : WGM;
        u.pm = fm + ((wgid % nig) % gsz); u.pn = (wgid % nig) / gsz; return true;
    }
    __device__ __forceinline__ void a_ready(const Unit&) const {}
    __device__ __forceinline__ void done(const Unit&) const {}
};

struct EpiSwiglu {
    static constexpr bool PERM = true, AFTER_DRAIN = false;
    h16* O; int ldc;
    __device__ __forceinline__ void operator()(const f32x4 (&acc)[2][2][4][2], const Unit& u, int wr, int wc, int fr, int fq) const {
        const int row0 = u.pm * BM + wr * 64 + fr; const int col0 = u.pn * HALF + wc * 32 + 8 * fq;
#pragma unroll
        for (int ai = 0; ai < 2; ++ai)
#pragma unroll
            for (int m = 0; m < 4; ++m) {
                h16* rowp = O + (size_t)(row0 + ai * HALF + m * 16) * ldc + col0;
                const f32x4 g0 = acc[ai][0][m][0], g1 = acc[ai][0][m][1], u0 = acc[ai][1][m][0], u1 = acc[ai][1][m][1];
                u32x4 w;
                w.x = pkh(silu_f(g0[0]) * u0[0], silu_f(g0[1]) * u0[1]); w.y = pkh(silu_f(g0[2]) * u0[2], silu_f(g0[3]) * u0[3]);
                w.z = pkh(silu_f(g1[0]) * u1[0], silu_f(g1[1]) * u1[1]); w.w = pkh(silu_f(g1[2]) * u1[2], silu_f(g1[3]) * u1[3]);
                *(u32x4*)rowp = w;
            }
    }
};
struct EpiResid {
    static constexpr bool PERM = false, AFTER_DRAIN = false;
    const float* base; float* out; int ldc; float alpha, s;
    __device__ __forceinline__ void operator()(const f32x4 (&acc)[2][2][4][2], const Unit& u, int wr, int wc, int fr, int fq) const {
        const int col0 = u.pn * BM + wc * 32 + 4 * fq;
#pragma unroll
        for (int ai = 0; ai < 2; ++ai)
#pragma unroll
            for (int m = 0; m < 4; ++m) { const size_t off = (size_t)(u.pm * BM + ai * HALF + wr * 64 + m * 16 + fr) * ldc + col0;
#pragma unroll
                for (int bj = 0; bj < 2; ++bj)
#pragma unroll
                    for (int n = 0; n < 2; ++n) { const f32x4 bs = *(const f32x4*)(base + off + bj * HALF + n * 16); *(f32x4*)(out + off + bj * HALF + n * 16) = bs * alpha + acc[ai][bj][m][n] * s; } }
    }
};
struct EpiWin {
    static constexpr bool PERM = true, AFTER_DRAIN = false;
    h16* p16base; size_t p16stride;
    h16* ki16; float* wi;
    float* dout;
    __device__ __forceinline__ void operator()(const f32x4 (&acc)[2][2][4][2], const Unit& u, int wr, int wc, int fr, int fq) const {
        const int row0 = u.pm * BM + wr * 64 + fr;
        if (u.pn < 16) {
            const int seg = u.pn >> 1; h16* base = p16base + (size_t)seg * p16stride; const int colt = (u.pn & 1) * 256 + wc * 32 + 8 * fq;
            float* o32 = nullptr; float* o32s = nullptr;
            if (seg == 1) { o32 = dout + O_KP; o32s = dout + O_KS; } else if (seg == 2) { o32 = dout + O_VP; o32s = dout + O_VS; }
#pragma unroll
            for (int ai = 0; ai < 2; ++ai)
#pragma unroll
                for (int m = 0; m < 4; ++m) { const int row = row0 + ai * HALF + m * 16;
#pragma unroll
                    for (int bj = 0; bj < 2; ++bj) { const f32x4 v0 = acc[ai][bj][m][0], v1 = acc[ai][bj][m][1]; const int col = colt + bj * HALF;
                        u32x4 w; w.x = pkh(v0[0], v0[1]); w.y = pkh(v0[2], v0[3]); w.z = pkh(v1[0], v1[1]); w.w = pkh(v1[2], v1[3]);
                        *(u32x4*)(base + (size_t)row * 512 + col) = w;
                        if (o32) { float* d = nullptr; if (row < MP) d = o32 + (size_t)row * 512 + col; else if (row < MV) d = o32s + (size_t)(row - MP) * 512 + col;
                            if (d) { *(f32x4*)d = v0; *(f32x4*)(d + 4) = v1; } } } }
        } else {
#pragma unroll
            for (int ai = 0; ai < 2; ++ai)
#pragma unroll
                for (int m = 0; m < 4; ++m) { const int row = row0 + ai * HALF + m * 16; const f32x4 v0 = acc[ai][0][m][0], v1 = acc[ai][0][m][1];
                    if (wc < 2) { const int col = wc * 32 + 8 * fq;
                        u32x4 w; w.x = pkh(v0[0], v0[1]); w.y = pkh(v0[2], v0[3]); w.z = pkh(v1[0], v1[1]); w.w = pkh(v1[2], v1[3]);
                        *(u32x4*)(ki16 + (size_t)row * 64 + col) = w;
                        float* d = nullptr; if (row < MP) d = dout + O_KIP + (size_t)row * 64 + col; else if (row < MV) d = dout + O_KIS + (size_t)(row - MP) * 64 + col;
                        if (d) { *(f32x4*)d = v0; *(f32x4*)(d + 4) = v1; }
                    } else if (wc == 2 && fq == 0) { *(f32x4*)(wi + (size_t)row * 8) = v0; *(f32x4*)(wi + (size_t)row * 8 + 4) = v1; } }
        }
    }
};

template <class Epi, class Sched, bool ALIGN_EPI = false>
__device__ __forceinline__ void gemm_phase(LAS unsigned char* lds, const Gemm g, const Sched& S, const Epi& E) {
    const int tid = threadIdx.x, wid = __builtin_amdgcn_readfirstlane(tid >> 6), lane = tid & 63, wr = wid >> 2, wc = wid & 3, fr = lane & 15, fq = lane >> 4;
    const int K = g.K, nt = K / BK;
    unsigned voffA[2], voffB[2];
#pragma unroll
    for (int i = 0; i < 2; ++i) { int R, C; stage_rc(tid * 16 + i * 8192, R, C); const int Rb = Epi::PERM ? ((R & ~31) + perm32(R & 31)) : R;
        voffA[i] = (unsigned)(R * K + C) * 2u; voffB[i] = (unsigned)(Rb * K + C) * 2u; }
    const size_t kstep = (size_t)(BK * 2);
    const size_t hstep = (size_t)HALF * K * 2;
    const size_t tstep = 2 * hstep;
    const unsigned ldsw = (unsigned)wid * 1024u;
    const int aoff = lds_byte(wr * 64 + fr, fq * 8), boff = lds_byte(wc * 32 + fr, fq * 8);
#define PG8_SA(b, h) (((b) * 2 + (h)) * HTB)
#define PG8_SB(b, h) ((4 + (b) * 2 + (h)) * HTB)
#define PG8_STAGE(bufoff, gbase, voff) do { _Pragma("unroll") for (int _i = 0; _i < 2; ++_i) \
        __builtin_amdgcn_global_load_lds((const unsigned*)((const char*)(gbase) + (voff)[_i]), (LAS unsigned*)(lds + (bufoff) + ldsw + _i * 8192), 16, 0, 0); } while (0)
#define PG8_LDA(dst, b, h) do { _Pragma("unroll") for (int m = 0; m < 4; ++m) _Pragma("unroll") for (int k = 0; k < 2; ++k) dst[m][k] = *(const LAS s16x8*)(lds + PG8_SA(b, h) + aoff + m * 2048 + k * 1024); } while (0)
#define PG8_LDB(dst, b, h) do { _Pragma("unroll") for (int n = 0; n < 2; ++n) _Pragma("unroll") for (int k = 0; k < 2; ++k) dst[n][k] = *(const LAS s16x8*)(lds + PG8_SB(b, h) + boff + n * 2048 + k * 1024); } while (0)
#define PG8_MMA(ai, bj, At, Bt) do { __builtin_amdgcn_s_setprio(1); _Pragma("unroll") for (int m = 0; m < 4; ++m) _Pragma("unroll") for (int n = 0; n < 2; ++n) _Pragma("unroll") for (int k = 0; k < 2; ++k) \
        acc[ai][bj][m][n] = __builtin_amdgcn_mfma_f32_16x16x32_f16(__builtin_bit_cast(f16x8, Bt[n][k]), __builtin_bit_cast(f16x8, At[m][k]), acc[ai][bj][m][n], 0, 0, 0); __builtin_amdgcn_s_setprio(0); } while (0)
#define PG8_WAIT_V(n) asm volatile("s_waitcnt vmcnt(" #n ")" ::: "memory")
#define PG8_WAIT_L(n) asm volatile("s_waitcnt lgkmcnt(" #n ")" ::: "memory")
#define PG8_BAR __builtin_amdgcn_s_barrier()
#define PG8_SCHED __builtin_amdgcn_sched_barrier(0)
    Unit cur, nxt; int ui = 0;
    if (!S.next(0, cur)) return;
    f32x4 acc[2][2][4][2];
#pragma unroll
    for (int a = 0; a < 2; ++a)
#pragma unroll
        for (int b = 0; b < 2; ++b)
#pragma unroll
            for (int m = 0; m < 4; ++m)
#pragma unroll
                for (int n = 0; n < 2; ++n) acc[a][b][m][n] = (f32x4){0.f, 0.f, 0.f, 0.f};
    s16x8 At[4][2], B0[2][2], B1[2][2];
    const char* cA = (const char*)g.A + (size_t)cur.pm * tstep; const char* cB = (const char*)g.Bt + (size_t)cur.pn * tstep;
    S.a_ready(cur);
    PG8_STAGE(PG8_SB(0, 0), cB, voffB); PG8_STAGE(PG8_SB(0, 1), cB + hstep, voffB); PG8_STAGE(PG8_SA(0, 0), cA, voffA); PG8_STAGE(PG8_SA(0, 1), cA + hstep, voffA);
    if (wr == 1) PG8_BAR;
    PG8_WAIT_V(2); PG8_BAR;
    PG8_STAGE(PG8_SB(1, 0), cB + kstep, voffB); PG8_STAGE(PG8_SA(1, 0), cA + kstep, voffA); PG8_STAGE(PG8_SB(1, 1), cB + hstep + kstep, voffB);
    PG8_WAIT_V(6); PG8_BAR;
    for (;;) {
        const bool has_next = S.next(ui + 1, nxt);
        const char* nA = has_next ? (const char*)g.A + (size_t)nxt.pm * tstep : cA; const char* nB = has_next ? (const char*)g.Bt + (size_t)nxt.pn * tstep : cB;
        for (int t = 0; t < nt; t += 2) {
            const bool last = (t == nt - 2);
            const char* a1 = cA + (size_t)(t + 1) * kstep;
            const char* a2 = last ? nA : cA + (size_t)(t + 2) * kstep; const char* b2 = last ? nB : cB + (size_t)(t + 2) * kstep;
            const char* a3 = a2 + kstep; const char* b3 = b2 + kstep;
            if (last && has_next) S.a_ready(nxt);
            PG8_LDB(B0, 0, 0); PG8_LDB(B1, 0, 1); PG8_SCHED; PG8_LDA(At, 0, 0); PG8_STAGE(PG8_SA(1, 1), a1 + hstep, voffA);
            PG8_WAIT_V(8); PG8_WAIT_L(0); PG8_BAR; PG8_MMA(0, 0, At, B0); PG8_MMA(0, 1, At, B1); PG8_BAR; PG8_SCHED;
            PG8_LDA(At, 0, 1); PG8_STAGE(PG8_SB(0, 0), b2, voffB); PG8_STAGE(PG8_SB(0, 1), b2 + hstep, voffB); PG8_STAGE(PG8_SA(0, 0), a2, voffA);
            PG8_WAIT_V(8); PG8_WAIT_L(0); PG8_BAR; PG8_MMA(1, 0, At, B0); PG8_MMA(1, 1, At, B1); PG8_BAR; PG8_SCHED;
            PG8_LDB(B0, 1, 0); PG8_LDB(B1, 1, 1); PG8_SCHED; PG8_LDA(At, 1, 0); PG8_STAGE(PG8_SA(0, 1), a2 + hstep, voffA);
            PG8_WAIT_V(8); PG8_WAIT_L(0); PG8_BAR; PG8_MMA(0, 0, At, B0); PG8_MMA(0, 1, At, B1); PG8_BAR; PG8_SCHED;
            PG8_LDA(At, 1, 1); PG8_STAGE(PG8_SB(1, 0), b3, voffB); PG8_STAGE(PG8_SB(1, 1), b3 + hstep, voffB); PG8_STAGE(PG8_SA(1, 0), a3, voffA);
            PG8_WAIT_V(8); PG8_WAIT_L(0); PG8_BAR; PG8_MMA(1, 0, At, B0); PG8_MMA(1, 1, At, B1); PG8_BAR; PG8_SCHED;
        }
        if constexpr (ALIGN_EPI) { if (wr == 0) PG8_BAR; }
        E(acc, cur, wr, wc, fr, fq); S.done(cur);
        if (!has_next) break;
#pragma unroll
        for (int a = 0; a < 2; ++a)
#pragma unroll
            for (int b = 0; b < 2; ++b)
#pragma unroll
                for (int m = 0; m < 4; ++m)
#pragma unroll
                    for (int n = 0; n < 2; ++n) acc[a][b][m][n] = (f32x4){0.f, 0.f, 0.f, 0.f};
        cur = nxt; cA = nA; cB = nB; ++ui;
        if constexpr (ALIGN_EPI) { if (wr == 1) PG8_BAR; }
    }
    PG8_WAIT_V(0);
    if constexpr (!ALIGN_EPI) { if (wr == 0) PG8_BAR; }
    PG8_BAR;
#undef PG8_SA
#undef PG8_SB
#undef PG8_STAGE
#undef PG8_LDA
#undef PG8_LDB
#undef PG8_MMA
#undef PG8_WAIT_V
#undef PG8_WAIT_L
#undef PG8_BAR
#undef PG8_SCHED
}
}

struct Args { const float* in[23]; const int* page_table; float* out; unsigned char* ws; int ph_lo, ph_hi; };
struct Frame {
    LAS unsigned char* lds;
    int tid, lane, wave, vcu, G;
};

__device__ __forceinline__ void p0_transpose_item(const float* W, int K, int N, int src0, int nvalid, h16* WT, int dst0, int kb, LAS float* scr, int lane) {
    const int k0 = 64 * kb;
#pragma unroll 8
    for (int i = 0; i < 32; ++i) { const int kk = 2 * i + (lane >> 5); const int n = lane & 31; scr[kk * 33 + n] = (n < nvalid) ? W[(size_t)(k0 + kk) * N + src0 + n] : 0.f; }
    LDS_WAIT(); asm volatile("" ::: "memory");
    const int c = lane & 7;
#pragma unroll
    for (int j = 0; j < 4; ++j) { const int n = (lane >> 3) + 8 * j; const LAS float* s = scr + (8 * c) * 33 + n;
        u32x4 o; o.x = pkh(s[0 * 33], s[1 * 33]); o.y = pkh(s[2 * 33], s[3 * 33]); o.z = pkh(s[4 * 33], s[5 * 33]); o.w = pkh(s[6 * 33], s[7 * 33]);
        *(GAS u32x4*)(WT + (size_t)(dst0 + n) * K + k0 + 8 * c) = o; }
    LDS_WAIT(); asm volatile("" ::: "memory");
}
__device__ __forceinline__ void p0_prologue(const Frame& F, const Args& a) {
    unsigned char* ws = a.ws;
    LAS float* scr = (LAS float*)(F.lds + F.wave * 16384);
    const int gw = F.vcu * NWAVES + F.wave, NGW = F.G * NWAVES;
    constexpr int I_G = 16 * 88, I_D = 44 * 32, I_IN = 16 * 136, I_O = 16 * 32;
    constexpr int NITEMS = 4 * I_G + 2 * I_D + I_IN + I_O;
    for (int it = gw; it < NITEMS; it += NGW) {
        int r = it;
        if (r < 4 * I_G) { const int which = r / I_G; r %= I_G; const int kb = r / 88, nb = r % 88, n0 = nb * 32;
            const float* W = a.in[which == 0 ? 8 : which == 1 ? 9 : which == 2 ? 18 : 19]; h16* WT = (h16*)(ws + (which < 2 ? WS_WGU1 : WS_WGU2));
            const int dst = (n0 / 128) * 256 + (n0 % 128) + ((which & 1) ? 128 : 0);
            p0_transpose_item(W, DM, DFF, n0, 32, WT, dst, kb, scr, F.lane); continue; }
        r -= 4 * I_G;
        if (r < 2 * I_D) { const int which = r / I_D; r %= I_D; const int kb = r / 32, nb = r % 32;
            p0_transpose_item(a.in[which == 0 ? 10 : 20], DFF, DM, nb * 32, 32, (h16*)(ws + (which == 0 ? WS_WD1 : WS_WD2)), nb * 32, kb, scr, F.lane); continue; }
        r -= 2 * I_D;
        if (r < I_IN) { const int kb = r / 136, d = r % 136; int src, nv;
            if (d < 64) { src = 32 * d; nv = 32; } else if (d < 128) { src = C_QR + 32 * (d - 64); nv = 32; } else if (d < 130) { src = C_KI + 32 * (d - 128); nv = 32; } else if (d == 130) { src = C_WI; nv = 8; } else { src = 0; nv = 0; }
            p0_transpose_item(a.in[13], DM, NIN, src, nv, (h16*)(ws + WS_WIN), 32 * d, kb, scr, F.lane); continue; }
        r -= I_IN;
        { const int kb = r / 32, nb = r % 32; p0_transpose_item(a.in[15], DM, DM, nb * 32, 32, (h16*)(ws + WS_WOUT), nb * 32, kb, scr, F.lane); }
    }
    h16* X16 = (h16*)(ws + WS_X16);
    for (int m = gw; m < MR; m += NGW) {
        const float* src = (m < MP) ? a.in[0] + (size_t)m * DM : (m < MV ? a.in[1] + (size_t)(m - MP) * DM : nullptr);
        GAS u32x2* o = (GAS u32x2*)(X16 + (size_t)m * DM) + F.lane;
#pragma unroll
        for (int j = 0; j < 4; ++j) { f32x4 v = src ? ((const GAS f32x4*)src)[F.lane + 64 * j] : (f32x4){0.f, 0.f, 0.f, 0.f}; u32x2 w; w.x = pkh(v[0], v[1]); w.y = pkh(v[2], v[3]); o[64 * j] = w; }
    }
    f32x2* ROT = (f32x2*)(ws + WS_ROT);
    for (int e = (F.vcu * NTHR + F.tid); e < 4097 * 64; e += F.G * NTHR) {
        const int p = e >> 6, i = e & 63; const float pos = (p < 4096) ? (float)p : 8192.f;
        const float freq = powf(10000.f, -(float)i / 64.f); const float ang = pos * freq;
        ROT[e] = (f32x2){cosf(ang), sinf(ang)};
    }
}

__device__ __forceinline__ void ln_rows(const Frame& F, const float* V, const float* g, const float* b, float* o32, h16* o16, int nrows) {
    const int gw = F.vcu * NWAVES + F.wave, NGW = F.G * NWAVES;
    f32x4 gv[4], bv[4];
#pragma unroll
    for (int j = 0; j < 4; ++j) { gv[j] = ((const GAS f32x4*)g)[F.lane + 64 * j]; bv[j] = ((const GAS f32x4*)b)[F.lane + 64 * j]; }
    for (int m = gw; m < nrows; m += NGW) {
        const GAS f32x4* xr = (const GAS f32x4*)(V + (size_t)m * DM) + F.lane;
        f32x4 v[4]; float s = 0.f;
#pragma unroll
        for (int j = 0; j < 4; ++j) { v[j] = xr[64 * j]; s += (v[j][0] + v[j][1]) + (v[j][2] + v[j][3]); }
        const float mean = wave_sum(s) * (1.f / DM); float s2 = 0.f;
#pragma unroll
        for (int j = 0; j < 4; ++j) { v[j] = v[j] - mean; s2 += (v[j][0] * v[j][0] + v[j][1] * v[j][1]) + (v[j][2] * v[j][2] + v[j][3] * v[j][3]); }
        const float rstd = 1.f / sqrtf(wave_sum(s2) * (1.f / DM) + LN_EPS);
#pragma unroll
        for (int j = 0; j < 4; ++j) { const f32x4 y = v[j] * rstd * gv[j] + bv[j];
            if (o32) ((GAS f32x4*)(o32 + (size_t)m * DM))[F.lane + 64 * j] = y;
            if (o16) { u32x2 w; w.x = pkh(y[0], y[1]); w.y = pkh(y[2], y[3]); ((GAS u32x2*)(o16 + (size_t)m * DM))[F.lane + 64 * j] = w; } }
    }
}

__device__ __forceinline__ int t5_bucket(int n) {
    if (n < 16) return n < 0 ? 0 : n;
    if (n >= 113) return 31;
    const int v = 16 + (int)(log2f((float)n * 0.0625f) * (16.0f / 3.0f));
    return v > 31 ? 31 : v;
}
__device__ __forceinline__ unsigned f2key(float x) { if (x == 0.f) x = 0.f; const unsigned u = __float_as_uint(x); return (u & 0x80000000u) ? ~u : (u | 0x80000000u); }

constexpr int QL_SC = 0;
constexpr int QL_HIST = 32832;
constexpr int QL_LIST = QL_HIST + 1024;
constexpr int QL_PHYS = QL_LIST + 1024;
constexpr int QL_LG = QL_PHYS + 1024;
constexpr int QL_QI = QL_LG + 8192;
constexpr int QL_QA = QL_QI + 2048;
constexpr int QL_BIAS = QL_QA + 2176;
constexpr int QL_MISC = QL_BIAS + 1024;
constexpr int QL_SCAN = QL_MISC + 256;
constexpr int QL_END = QL_SCAN + 2048;
static_assert(QL_END <= RING_BYTES, "query phase LDS");

template <bool SAMPLE>
__device__ __forceinline__ void sparse_query(const Frame& F, const Args& a, int qi  ) {
    unsigned char* ws = a.ws;
    LAS float* sc = (LAS float*)(F.lds + QL_SC); LAS unsigned* key = (LAS unsigned*)(F.lds + QL_SC);
    LAS unsigned* hist = (LAS unsigned*)(F.lds + QL_HIST); LAS int* list = (LAS int*)(F.lds + QL_LIST); LAS int* phys = (LAS int*)(F.lds + QL_PHYS);
    LAS float* lg = (LAS float*)(F.lds + QL_LG); LAS float* qis = (LAS float*)(F.lds + QL_QI); LAS float* qas = (LAS float*)(F.lds + QL_QA);
    LAS float* bias = (LAS float*)(F.lds + QL_BIAS); LAS unsigned* misc = (LAS unsigned*)(F.lds + QL_MISC); LAS int* scan = (LAS int*)(F.lds + QL_SCAN);
    const int tid = F.tid, lane = F.lane, wave = F.wave;
    const int row = SAMPLE ? MP + qi : qi;
    const int bb = SAMPLE ? qi : qi / SEQ, t = SAMPLE ? PAST : qi % SEQ;
    const int n = t + 1;
    const h16* QA = (const h16*)(ws + WS_QA); const h16* KA = (const h16*)(ws + WS_KA); const h16* VA = (const h16*)(ws + WS_VA);
    const h16* QI = (const h16*)(ws + WS_QI); const h16* KI = (const h16*)(ws + WS_KI); const float* WI = (const float*)(ws + WS_WI);
    const int* pt = a.page_table + bb * NPAGES;
    { const int h = tid >> 6, d = tid & 63;
      qis[d * 8 + h] = h2f(QI[(size_t)row * 512 + tid]) * 0.125f;
      qas[h * 68 + d] = h2f(QA[(size_t)row * 512 + tid]);
      if (tid < 256) bias[tid] = a.in[7][tid];
      if (tid < 8) ((LAS float*)misc)[32 + tid] = WI[(size_t)row * 8 + tid] * 0.35355339059327373f;
      if (tid == 0) misc[2] = 0u; }
    __syncthreads();
    int cnt;
    if (n > TOPK) {
        float wv[8];
#pragma unroll
        for (int h = 0; h < 8; ++h) wv[h] = ((LAS float*)misc)[32 + h];
        for (int s = tid; s < n; s += NTHR) {
            float acc[8];
#pragma unroll
            for (int h = 0; h < 8; ++h) acc[h] = 0.f;
            if (!SAMPLE || s == PAST) {
                const h16* kp = SAMPLE ? KI + (size_t)row * 64 : KI + (size_t)(bb * SEQ + s) * 64;
#pragma unroll
                for (int c = 0; c < 8; ++c) { const u32x4 w = *(const GAS u32x4*)(kp + 8 * c);
#pragma unroll
                    for (int e = 0; e < 4; ++e) { const unsigned ww = w[e]; const float k0 = hlo(ww), k1 = hhi(ww); const int d = 8 * c + 2 * e;
                        const f32x4 qa0 = *(const LAS f32x4*)(qis + d * 8), qa1 = *(const LAS f32x4*)(qis + d * 8 + 4), qb0 = *(const LAS f32x4*)(qis + d * 8 + 8), qb1 = *(const LAS f32x4*)(qis + d * 8 + 12);
                        acc[0] += qa0[0] * k0; acc[1] += qa0[1] * k0; acc[2] += qa0[2] * k0; acc[3] += qa0[3] * k0; acc[4] += qa1[0] * k0; acc[5] += qa1[1] * k0; acc[6] += qa1[2] * k0; acc[7] += qa1[3] * k0;
                        acc[0] += qb0[0] * k1; acc[1] += qb0[1] * k1; acc[2] += qb0[2] * k1; acc[3] += qb0[3] * k1; acc[4] += qb1[0] * k1; acc[5] += qb1[1] * k1; acc[6] += qb1[2] * k1; acc[7] += qb1[3] * k1; } }
            } else {
                const float* kp = a.in[4] + ((size_t)pt[s >> 7] * PAGE + (s & 127)) * 64;
#pragma unroll 4
                for (int c = 0; c < 16; ++c) { const f32x4 kv = *(const GAS f32x4*)(kp + 4 * c);
#pragma unroll
                    for (int e = 0; e < 4; ++e) { const float k0 = kv[e]; const int d = 4 * c + e;
                        const f32x4 qa0 = *(const LAS f32x4*)(qis + d * 8), qa1 = *(const LAS f32x4*)(qis + d * 8 + 4);
                        acc[0] += qa0[0] * k0; acc[1] += qa0[1] * k0; acc[2] += qa0[2] * k0; acc[3] += qa0[3] * k0; acc[4] += qa1[0] * k0; acc[5] += qa1[1] * k0; acc[6] += qa1[2] * k0; acc[7] += qa1[3] * k0; } }
            }
            float sco = 0.f;
#pragma unroll
            for (int h = 0; h < 8; ++h) sco += wv[h] * fmaxf(acc[h], 0.f);
            key[s] = f2key(sco);
        }
        __syncthreads();
        unsigned prefix = 0u; int r = TOPK;
#pragma unroll 1
        for (int pass = 0; pass < 4; ++pass) {
            const int shift = 24 - 8 * pass;
            if (tid < 256) hist[tid] = 0u;
            __syncthreads();
            for (int s = tid; s < n; s += NTHR) { const unsigned u = key[s]; if (pass == 0 || (u >> (shift + 8)) == prefix) __hip_atomic_fetch_add(hist + ((u >> shift) & 255u), 1u, __ATOMIC_RELAXED, __HIP_MEMORY_SCOPE_WORKGROUP); }
            __syncthreads();
            if (wave == 0) {
                int c[4]; int local = 0;
#pragma unroll
                for (int j = 0; j < 4; ++j) { c[j] = (int)hist[255 - (4 * lane + j)]; local += c[j]; }
                int incl = local;
#pragma unroll
                for (int o = 1; o < 64; o <<= 1) { const int v = __shfl_up(incl, o); if (lane >= o) incl += v; }
                const int excl = incl - local;
                if (excl < r && r <= incl) { int run = excl;
#pragma unroll
                    for (int j = 0; j < 4; ++j) { if (run < r && r <= run + c[j]) { misc[0] = (unsigned)(255 - (4 * lane + j)); misc[1] = (unsigned)(r - run); } run += c[j]; } }
            }
            __syncthreads();
            prefix = (prefix << 8) | misc[0]; r = (int)misc[1];
            __syncthreads();
        }
        const int chunk = (n + NTHR - 1) / NTHR; const int s0 = tid * chunk, s1 = (s0 + chunk < n) ? s0 + chunk : n;
        int neq = 0;
        for (int s = s0; s < s1; ++s) neq += (key[s] == prefix) ? 1 : 0;
        int incl = neq;
#pragma unroll
        for (int o = 1; o < 64; o <<= 1) { const int v = __shfl_up(incl, o); if (lane >= o) incl += v; }
        if (lane == 63) misc[16 + wave] = (unsigned)incl;
        __syncthreads();
        int ord = incl - neq;
        for (int w = 0; w < wave; ++w) ord += (int)misc[16 + w];
        for (int s = s0; s < s1; ++s) { const unsigned u = key[s]; bool take = u > prefix; if (u == prefix) { take = ord < r; ++ord; }
            if (take) { const unsigned p = __hip_atomic_fetch_add(misc + 2, 1u, __ATOMIC_RELAXED, __HIP_MEMORY_SCOPE_WORKGROUP); if (p < TOPK) list[p] = s; } }
        __syncthreads();
        cnt = TOPK;
    } else {
        if (tid < n) list[tid] = tid;
        __syncthreads();
        cnt = n;
    }
    if (tid < cnt) { const int s = list[tid]; int pr;
        if (SAMPLE) pr = (s >= PAST) ? -1 : pt[s >> 7] * PAGE + (s & 127); else pr = bb * SEQ + s;
        phys[tid] = pr; }
    __syncthreads();
    for (int p = tid; p < cnt * 8; p += NTHR) {
        const int k = p >> 3, h = p & 7; const int pr = phys[k]; float dot = 0.f;
        if (!SAMPLE) { const h16* kp = KA + (size_t)pr * 512 + h * 64;
#pragma unroll
            for (int c = 0; c < 8; ++c) { const u32x4 w = *(const GAS u32x4*)(kp + 8 * c);
#pragma unroll
                for (int e = 0; e < 4; ++e) dot += qas[h * 68 + 8 * c + 2 * e] * hlo(w[e]) + qas[h * 68 + 8 * c + 2 * e + 1] * hhi(w[e]); }
        } else { const float* kp = (pr < 0) ? a.out + O_KS + (size_t)qi * 512 + h * 64 : a.in[2] + (size_t)pr * 512 + h * 64;
#pragma unroll 4
            for (int c = 0; c < 16; ++c) { const f32x4 kv = *(const GAS f32x4*)(kp + 4 * c);
                dot += qas[h * 68 + 4 * c] * kv[0] + qas[h * 68 + 4 * c + 1] * kv[1] + qas[h * 68 + 4 * c + 2] * kv[2] + qas[h * 68 + 4 * c + 3] * kv[3]; } }
        lg[h * 256 + k] = dot * 0.125f + bias[t5_bucket(t - list[k]) * 8 + h];
    }
    __syncthreads();
    { float v[4]; float mx = -INFINITY;
#pragma unroll
      for (int j = 0; j < 4; ++j) { const int k = lane + 64 * j; v[j] = (k < cnt) ? lg[wave * 256 + k] : -INFINITY; mx = fmaxf(mx, v[j]); }
      mx = wave_max(mx); float sm = 0.f;
#pragma unroll
      for (int j = 0; j < 4; ++j) { v[j] = (lane + 64 * j < cnt) ? __expf(v[j] - mx) : 0.f; sm += v[j]; }
      sm = wave_sum(sm); const float inv = 1.f / sm;
#pragma unroll
      for (int j = 0; j < 4; ++j) lg[wave * 256 + lane + 64 * j] = v[j] * inv; }
    __syncthreads();
    { const int h = tid >> 6; float o = 0.f;
      if (!SAMPLE) {
          int k = 0;
          for (; k + 4 <= cnt; k += 4) { const float v0 = h2f(VA[(size_t)phys[k] * 512 + tid]), v1 = h2f(VA[(size_t)phys[k + 1] * 512 + tid]), v2 = h2f(VA[(size_t)phys[k + 2] * 512 + tid]), v3 = h2f(VA[(size_t)phys[k + 3] * 512 + tid]);
              o += lg[h * 256 + k] * v0 + lg[h * 256 + k + 1] * v1 + lg[h * 256 + k + 2] * v2 + lg[h * 256 + k + 3] * v3; }
          for (; k < cnt; ++k) o += lg[h * 256 + k] * h2f(VA[(size_t)phys[k] * 512 + tid]);
      } else {
          for (int k = 0; k < cnt; ++k) { const int pr = phys[k]; const float v = (pr < 0) ? a.out[O_VS + (size_t)qi * 512 + tid] : a.in[3][(size_t)pr * 512 + tid]; o += lg[h * 256 + k] * v; }
      }
      ((h16*)(ws + WS_MIX))[(size_t)row * DM + tid] = f2h(o); }
    __syncthreads();
}

constexpr int LDP = 136;
constexpr int RT_BYTES = 128 * LDP * 2;
static_assert(4 * RT_BYTES <= RING_BYTES + 8192, "retention LDS");
__device__ __forceinline__ void mm128(const LAS h16* A, const LAS h16* Bt, int wave, int lane, f32x4 (&acc)[8]) {
    const int r = lane & 15, q = lane >> 4;
#pragma unroll
    for (int ks = 0; ks < 4; ++ks) {
        const f16x8 av = __builtin_bit_cast(f16x8, *(const LAS s16x8*)(A + (16 * wave + r) * LDP + ks * 32 + q * 8));
#pragma unroll
        for (int nt = 0; nt < 8; ++nt) { const f16x8 bv = __builtin_bit_cast(f16x8, *(const LAS s16x8*)(Bt + (16 * nt + r) * LDP + ks * 32 + q * 8));
            acc[nt] = __builtin_amdgcn_mfma_f32_16x16x32_f16(av, bv, acc[nt], 0, 0, 0); }
    }
}
__device__ __forceinline__ float gamma_log2(int h) { return log2f(1.0f - exp2f(-5.0f - (float)h)); }
template <bool TRANS>
__device__ __forceinline__ void load_rot(const Frame& F, const h16* src  , const f32x2* rot  , LAS h16* dst, float scale, float lg2, int decay_mode  ) {
    for (int e = F.tid; e < 128 * 64; e += NTHR) { const int j = e >> 6, i = e & 63;
        const float x1 = h2f(src[(size_t)j * 512 + i]), x2 = h2f(src[(size_t)j * 512 + 64 + i]); const f32x2 cs = rot[j * 64 + i];
        float sc = scale; if (decay_mode == 1) sc *= exp2f((float)(127 - j) * lg2);
        const float o1 = (x1 * cs[0] - x2 * cs[1]) * sc, o2 = (x1 * cs[1] + x2 * cs[0]) * sc;
        if (TRANS) { dst[i * LDP + j] = f2h(o1); dst[(64 + i) * LDP + j] = f2h(o2); } else { dst[j * LDP + i] = f2h(o1); dst[j * LDP + 64 + i] = f2h(o2); } }
}
__device__ __forceinline__ void ret_kv_unit(const Frame& F, const Args& a, int unit) {
    unsigned char* ws = a.ws; const int c = unit & 31, h = (unit >> 5) & 3, b = unit >> 7;
    LAS h16* Kt = (LAS h16*)(F.lds); LAS h16* Vt = (LAS h16*)(F.lds + RT_BYTES);
    const size_t row0 = (size_t)b * SEQ + c * 128; const float lg2 = gamma_log2(h);
    load_rot<true>(F, (const h16*)(ws + WS_KR) + row0 * 512 + h * 128, (const f32x2*)(ws + WS_ROT) + (size_t)(c * 128) * 64, Kt, 0.08838834764831845f, lg2, 1);
    const h16* V = (const h16*)(ws + WS_VR) + row0 * 512 + h * 128;
    for (int e = F.tid; e < 128 * 128; e += NTHR) { const int j = e >> 7, d = e & 127; Vt[d * LDP + j] = V[(size_t)j * 512 + d]; }
    __syncthreads();
    f32x4 acc[8];
#pragma unroll
    for (int i = 0; i < 8; ++i) acc[i] = (f32x4){0.f, 0.f, 0.f, 0.f};
    mm128(Kt, Vt, F.wave, F.lane, acc);
    float* KVC = (float*)(ws + WS_KVC) + (size_t)unit * 16384; const int r = F.lane & 15, q = F.lane >> 4;
#pragma unroll
    for (int nt = 0; nt < 8; ++nt)
#pragma unroll
        for (int g = 0; g < 4; ++g) KVC[(16 * F.wave + 4 * q + g) * 128 + 16 * nt + r] = acc[nt][g];
    __syncthreads();
}
__device__ __forceinline__ void ret_scan(const Frame& F, const Args& a) {
    unsigned char* ws = a.ws; const float* KVC = (const float*)(ws + WS_KVC); float* SC = (float*)(ws + WS_SC);
    for (int e = F.vcu * NTHR + F.tid; e < NB * HR * 16384; e += F.G * NTHR) {
        const int bh = e >> 14, el = e & 16383, h = bh & 3; const float cd = exp2f(128.0f * gamma_log2(h));
        float s = 0.f;
        for (int c = 0; c < 32; ++c) { SC[((size_t)bh * 32 + c) * 16384 + el] = s; s = cd * s + KVC[((size_t)bh * 32 + c) * 16384 + el]; }
        a.out[O_RSP + (size_t)bh * 16384 + el] = s;
    }
}
__device__ __forceinline__ void ret_out_unit(const Frame& F, const Args& a, int unit) {
    unsigned char* ws = a.ws; const int c = unit & 31, h = (unit >> 5) & 3, b = unit >> 7;
    LAS h16* Qs = (LAS h16*)(F.lds); LAS h16* Ks = (LAS h16*)(F.lds + RT_BYTES); LAS h16* Vt = (LAS h16*)(F.lds + 2 * RT_BYTES); LAS h16* St = (LAS h16*)(F.lds + 3 * RT_BYTES);
    const size_t row0 = (size_t)b * SEQ + c * 128; const float lg2 = gamma_log2(h);
    const f32x2* rot = (const f32x2*)(ws + WS_ROT) + (size_t)(c * 128) * 64;
    load_rot<false>(F, (const h16*)(ws + WS_QR) + row0 * 512 + h * 128, rot, Qs, 1.0f, lg2, 0);
    load_rot<false>(F, (const h16*)(ws + WS_KR) + row0 * 512 + h * 128, rot, Ks, 0.08838834764831845f, lg2, 0);
    const h16* V = (const h16*)(ws + WS_VR) + row0 * 512 + h * 128;
    for (int e = F.tid; e < 128 * 128; e += NTHR) { const int j = e >> 7, d = e & 127; Vt[d * LDP + j] = V[(size_t)j * 512 + d]; }
    const float* S = (const float*)(ws + WS_SC) + (size_t)unit * 16384;
    for (int e = F.tid; e < 128 * 128; e += NTHR) { const int dk = e >> 7, dv = e & 127; St[dv * LDP + dk] = f2h(S[e]); }
    __syncthreads();
    const int r = F.lane & 15, q = F.lane >> 4;
    f32x4 acc[8];
#pragma unroll
    for (int i = 0; i < 8; ++i) acc[i] = (f32x4){0.f, 0.f, 0.f, 0.f};
    mm128(Qs, Ks, F.wave, F.lane, acc);
    __syncthreads();
#pragma unroll
    for (int nt = 0; nt < 8; ++nt)
#pragma unroll
        for (int g = 0; g < 4; ++g) { const int i = 16 * F.wave + 4 * q + g, j = 16 * nt + r; const float v = (i >= j) ? acc[nt][g] * exp2f((float)(i - j) * lg2) : 0.f; Ks[i * LDP + j] = f2h(v); }
    __syncthreads();
    f32x4 o1[8], o2[8];
#pragma unroll
    for (int i = 0; i < 8; ++i) { o1[i] = (f32x4){0.f, 0.f, 0.f, 0.f}; o2[i] = (f32x4){0.f, 0.f, 0.f, 0.f}; }
    mm128(Ks, Vt, F.wave, F.lane, o1);
    mm128(Qs, St, F.wave, F.lane, o2);
    const float* gng = a.in[14] + h * 128; const h16* GR = (const h16*)(ws + WS_GR); h16* MIX = (h16*)(ws + WS_MIX);
#pragma unroll
    for (int g = 0; g < 4; ++g) { const int i = 16 * F.wave + 4 * q + g; const float cross = exp2f((float)(i + 1) * lg2);
        float v[8]; float s = 0.f;
#pragma unroll
        for (int nt = 0; nt < 8; ++nt) { v[nt] = o1[nt][g] + cross * o2[nt][g]; s += v[nt]; }
        s += __shfl_xor(s, 1); s += __shfl_xor(s, 2); s += __shfl_xor(s, 4); s += __shfl_xor(s, 8);
        const float mu = s * (1.f / 128.f); float s2 = 0.f;
#pragma unroll
        for (int nt = 0; nt < 8; ++nt) { v[nt] -= mu; s2 += v[nt] * v[nt]; }
        s2 += __shfl_xor(s2, 1); s2 += __shfl_xor(s2, 2); s2 += __shfl_xor(s2, 4); s2 += __shfl_xor(s2, 8);
        const float rstd = 1.f / sqrtf(s2 * (1.f / 128.f) + GN_EPS);
        const size_t row = row0 + i;
#pragma unroll
        for (int nt = 0; nt < 8; ++nt) { const int dv = 16 * nt + r; const float gt = h2f(GR[row * 512 + h * 128 + dv]);
            MIX[row * DM + 512 + h * 128 + dv] = f2h(v[nt] * rstd * gng[dv] * silu_f(gt)); } }
    __syncthreads();
}
__device__ __forceinline__ void ret_sample_unit(const Frame& F, const Args& a, int unit) {
    unsigned char* ws = a.ws; const int h = unit & 3, b = unit >> 2; const int row = MP + b;
    LAS float* qs = (LAS float*)(F.lds); LAS float* ks = qs + 128; LAS float* part = ks + 128; LAS float* red = part + 512;
    const float lg2 = gamma_log2(h); const float gam = exp2f(lg2);
    const f32x2* rot = (const f32x2*)(ws + WS_ROT) + (size_t)4096 * 64;
    if (F.tid < 128) { const int i = F.tid & 63; const bool second = F.tid >= 64;
        const h16* src = (const h16*)(ws + (F.tid < 128 ? WS_QR : WS_KR)) + (size_t)row * 512 + h * 128;
        const float x1 = h2f(src[i]), x2 = h2f(src[64 + i]); const f32x2 cs = rot[i];
        qs[F.tid] = second ? (x1 * cs[1] + x2 * cs[0]) : (x1 * cs[0] - x2 * cs[1]);
    } else if (F.tid < 256) { const int tt = F.tid - 128; const int i = tt & 63; const bool second = tt >= 64;
        const h16* src = (const h16*)(ws + WS_KR) + (size_t)row * 512 + h * 128;
        const float x1 = h2f(src[i]), x2 = h2f(src[64 + i]); const f32x2 cs = rot[i];
        ks[tt] = (second ? (x1 * cs[1] + x2 * cs[0]) : (x1 * cs[0] - x2 * cs[1])) * 0.08838834764831845f;
    }
    __syncthreads();
    const int dv = F.tid & 127, qd = F.tid >> 7;
    const float v = h2f(((const h16*)(ws + WS_VR))[(size_t)row * 512 + h * 128 + dv]);
    const float* S0 = a.in[5] + ((size_t)b * HR + h) * 16384; float* SN = a.out + O_RSS + ((size_t)b * HR + h) * 16384;
    float po = 0.f, qk = 0.f;
    for (int dk = 32 * qd; dk < 32 * qd + 32; ++dk) { const float s0 = S0[dk * 128 + dv]; po += qs[dk] * s0; SN[dk * 128 + dv] = gam * s0 + ks[dk] * v; qk += qs[dk] * ks[dk]; }
    part[qd * 128 + dv] = po; if (dv == 0) red[qd] = qk;
    __syncthreads();
    if (F.tid < 128) {
        const float qkt = red[0] + red[1] + red[2] + red[3];
        float o = qkt * v + gam * (part[dv] + part[128 + dv] + part[256 + dv] + part[384 + dv]);
        float s = wave_sum(o); if (F.lane == 0) red[8 + F.wave] = s;
        asm volatile("s_waitcnt lgkmcnt(0)" ::: "memory");
        part[dv] = o;
    }
    __syncthreads();
    if (F.tid < 128) {
        const float mu = (red[8] + red[9]) * (1.f / 128.f); const float o = part[dv] - mu;
        float s2 = wave_sum(o * o); if (F.lane == 0) red[12 + F.wave] = s2;
    }
    __syncthreads();
    if (F.tid < 128) {
        const float mu = (red[8] + red[9]) * (1.f / 128.f); const float o = part[dv] - mu;
        const float rstd = 1.f / sqrtf((red[12] + red[13]) * (1.f / 128.f) + GN_EPS);
        const float gt = h2f(((const h16*)(ws + WS_GR))[(size_t)row * 512 + h * 128 + dv]);
        ((h16*)(ws + WS_MIX))[(size_t)row * DM + 512 + h * 128 + dv] = f2h(o * rstd * a.in[14][h * 128 + dv] * silu_f(gt));
    }
    __syncthreads();
}

constexpr int N_PHASES = 13;
__global__ void __launch_bounds__(NTHR, 2) skel_fwd(Args args) {
    extern __shared__ __attribute__((aligned(16))) unsigned char lds[];
    Frame F;
    F.lds = (LAS unsigned char*)lds;
    F.tid = threadIdx.x; F.lane = F.tid & 63; F.wave = __builtin_amdgcn_readfirstlane(F.tid >> 6);
    F.G = gridDim.x; { const int bx = blockIdx.x; F.vcu = (F.G % 8 == 0) ? (bx % 8) * (F.G / 8) + bx / 8 : bx; }
    unsigned char* ws = args.ws;
    const int lo = args.ph_lo, hi = args.ph_hi;
#define IN(k) (lo <= (k) && (k) < hi)
    if (IN(0)) { p0_prologue(F, args); }
    if (IN(1)) {
        pg8::Gemm g{(const h16*)(ws + WS_X16), (const h16*)(ws + WS_WGU1), MR, 2 * DFF, DM}; pg8::StaticOrder S; S.init(MR, 2 * DFF, F.G, (int)blockIdx.x);
        pg8::EpiSwiglu E{(h16*)(ws + WS_H1), DFF};
        pg8::gemm_phase<pg8::EpiSwiglu, pg8::StaticOrder, true>(F.lds, g, S, E);
    }
    if (IN(2)) {
        pg8::Gemm g{(const h16*)(ws + WS_H1), (const h16*)(ws + WS_WD1), MR, DM, DFF}; pg8::StaticOrder S; S.init(MR, DM, F.G, (int)blockIdx.x);
        pg8::EpiResid E{(const float*)(ws + WS_HF), (float*)(ws + WS_V), DM, ALPHA, 0.5f};
        pg8::gemm_phase<pg8::EpiResid, pg8::StaticOrder, true>(F.lds, g, S, E);
    }
    if (IN(3)) { ln_rows(F, (const float*)(ws + WS_V), args.in[11], args.in[12], (float*)(ws + WS_HF), (h16*)(ws + WS_H16), MV); }
    if (IN(4)) {
        pg8::Gemm g{(const h16*)(ws + WS_H16), (const h16*)(ws + WS_WIN), MR, NINP, DM}; pg8::StaticOrder S; S.init(MR, NINP, F.G, (int)blockIdx.x);
        pg8::EpiWin E; E.p16base = (h16*)(ws + WS_QA); E.p16stride = SZ_P16 / 2;
        E.ki16 = (h16*)(ws + WS_KI); E.wi = (float*)(ws + WS_WI); E.dout = args.out;
        pg8::gemm_phase<pg8::EpiWin, pg8::StaticOrder, true>(F.lds, g, S, E);
    }
    if (IN(5)) {
        for (int u = F.vcu; u < NB * HR * 32; u += F.G) ret_kv_unit(F, args, u);
        for (int qi = F.vcu; qi < MP + NS; qi += F.G) { if (qi < NS) sparse_query<true>(F, args, qi); else sparse_query<false>(F, args, qi - NS); }
    }
    if (IN(6)) { ret_scan(F, args); for (int u = F.vcu; u < NS * HR; u += F.G) ret_sample_unit(F, args, u); }
    if (IN(7)) { for (int u = F.vcu; u < NB * HR * 32; u += F.G) ret_out_unit(F, args, u); }
    if (IN(8)) {
        pg8::Gemm g{(const h16*)(ws + WS_MIX), (const h16*)(ws + WS_WOUT), MR, DM, DM}; pg8::StaticOrder S; S.init(MR, DM, F.G, (int)blockIdx.x);
        pg8::EpiResid E{(const float*)(ws + WS_HF), (float*)(ws + WS_V), DM, ALPHA, 1.0f};
        pg8::gemm_phase<pg8::EpiResid, pg8::StaticOrder, true>(F.lds, g, S, E);
    }
    if (IN(9)) { ln_rows(F, (const float*)(ws + WS_V), args.in[16], args.in[17], (float*)(ws + WS_HF), (h16*)(ws + WS_H16), MV); }
    if (IN(10)) {
        pg8::Gemm g{(const h16*)(ws + WS_H16), (const h16*)(ws + WS_WGU2), MR, 2 * DFF, DM}; pg8::StaticOrder S; S.init(MR, 2 * DFF, F.G, (int)blockIdx.x);
        pg8::EpiSwiglu E{(h16*)(ws + WS_H1), DFF};
        pg8::gemm_phase<pg8::EpiSwiglu, pg8::StaticOrder, true>(F.lds, g, S, E);
    }
    if (IN(11)) {
        pg8::Gemm g{(const h16*)(ws + WS_H1), (const h16*)(ws + WS_WD2), MR, DM, DFF}; pg8::StaticOrder S; S.init(MR, DM, F.G, (int)blockIdx.x);
        pg8::EpiResid E{(const float*)(ws + WS_HF), (float*)(ws + WS_V), DM, ALPHA, 0.5f};
        pg8::gemm_phase<pg8::EpiResid, pg8::StaticOrder, true>(F.lds, g, S, E);
    }
    if (IN(12)) { ln_rows(F, (const float*)(ws + WS_V), args.in[21], args.in[22], args.out + O_Y, nullptr, MV); }
#undef IN
}

__global__ void __launch_bounds__(256) copy_x(const float* xp, const float* xs, float* hf) {
    const size_t n4 = (size_t)MR * DM / 4;
    for (size_t i = (size_t)blockIdx.x * 256 + threadIdx.x; i < n4; i += (size_t)gridDim.x * 256) {
        const size_t e = i * 4; f32x4 v = (f32x4){0.f, 0.f, 0.f, 0.f};
        if (e < (size_t)MP * DM) v = *(const f32x4*)(xp + e); else if (e < (size_t)MV * DM) v = *(const f32x4*)(xs + (e - (size_t)MP * DM));
        *(f32x4*)(hf + e) = v;
    }
}

extern "C" void kernel_launch(void* const* d_in, const int* in_sizes, int n_in, void* d_out, int out_size, void* d_ws, size_t ws_size, hipStream_t stream) {
    static int grid = 0;
    if (grid == 0) {
        if (n_in != 23 || out_size != (int)O_END || ws_size < WS_END) { fprintf(stderr, "kernel_launch: unexpected sizes (n_in %d out %d ws %zu need %zu)\n", n_in, out_size, ws_size, (size_t)WS_END); grid = -1; return; }
        int dev = 0, cus = 0;
        if (hipGetDevice(&dev) != hipSuccess || hipDeviceGetAttribute(&cus, hipDeviceAttributeMultiprocessorCount, dev) != hipSuccess) { grid = -1; return; }
        if (hipFuncSetAttribute((const void*)skel_fwd, hipFuncAttributeMaxDynamicSharedMemorySize, LDS_BYTES) != hipSuccess) { fprintf(stderr, "kernel_launch: hipFuncSetAttribute failed\n"); grid = -1; return; }
        (void)hipGetLastError();
        grid = cus;
    }
    if (grid < 0) return;
    Args a{};
    for (int i = 0; i < 23; ++i) a.in[i] = (const float*)d_in[i];
    a.page_table = (const int*)d_in[6];
    a.out = (float*)d_out; a.ws = (unsigned char*)d_ws;
    copy_x<<<1024, 256, 0, stream>>>(a.in[0], a.in[1], (float*)((unsigned char*)d_ws + WS_HF));
    for (int ph = 0; ph < N_PHASES; ++ph) {
        a.ph_lo = ph; a.ph_hi = ph + 1;
        hipLaunchKernelGGL(skel_fwd, dim3(grid), dim3(NTHR), LDS_BYTES, stream, a);
    }
}
```

```cpp
#include <hip/hip_runtime.h>
#include <cstdio>
#include <cstdint>

#define LAS __attribute__((address_space(3)))
#define GAS __attribute__((address_space(1)))
typedef unsigned short h16;
typedef short s16x8 __attribute__((ext_vector_type(8)));
typedef _Float16 f16x8 __attribute__((ext_vector_type(8)));
typedef _Float16 f16x2 __attribute__((ext_vector_type(2)));
typedef float f32x2 __attribute__((ext_vector_type(2)));
typedef float f32x4 __attribute__((ext_vector_type(4)));
typedef unsigned u32x4 __attribute__((ext_vector_type(4)));
typedef unsigned u32x2 __attribute__((ext_vector_type(2)));
typedef GAS unsigned gu32;

constexpr int DM = 1024, NB = 4, SEQ = 4096, MP = NB * SEQ, NS = 32, MR = MP + 256, MV = MP + NS, DFF = 2816;
constexpr int WA = 512, WRT = 512, HA = 8, DHA = 64, HR = 4, DKR = 128;
constexpr int NIN = 4168, NINP = 4352;
constexpr int PAST = 8192, PAGE = 128, NPAGES = 64, LS = PAST + 1, TOPK = 256;
constexpr float ALPHA = 1.189207115002721f;
constexpr float LN_EPS = 1e-5f, GN_EPS = 1e-5f;
constexpr int C_QA = 0, C_KA = 512, C_VA = 1024, C_QI = 1536, C_KI = 2048, C_WI = 2112, C_QR = 2120, C_KR = 2632, C_VR = 3144, C_GR = 3656;
constexpr size_t O_Y = 0, O_YS = (size_t)MP * DM, O_KP = O_YS + (size_t)NS * DM, O_VP = O_KP + (size_t)MP * WA, O_KIP = O_VP + (size_t)MP * WA,
                 O_RSP = O_KIP + (size_t)MP * 64, O_KS = O_RSP + (size_t)NB * HR * 128 * 128, O_VS = O_KS + (size_t)NS * WA, O_KIS = O_VS + (size_t)NS * WA,
                 O_RSS = O_KIS + (size_t)NS * 64, O_END = O_RSS + (size_t)NS * HR * 128 * 128;
static_assert(O_END == 37029888, "d_out size");

constexpr size_t MiB = 1u << 20;
constexpr size_t al(size_t x) { return (x + MiB - 1) / MiB * MiB; }
constexpr size_t WS_CTL = 0, CTL_ZERO_BYTES = 1 * MiB;
constexpr size_t WS_WGU1 = 2 * MiB;
constexpr size_t WS_WD1 = WS_WGU1 + al((size_t)2 * DFF * DM * 2);
constexpr size_t WS_WIN = WS_WD1 + al((size_t)DM * DFF * 2);
constexpr size_t WS_WOUT = WS_WIN + al((size_t)NINP * DM * 2);
constexpr size_t WS_WGU2 = WS_WOUT + al((size_t)DM * DM * 2);
constexpr size_t WS_WD2 = WS_WGU2 + al((size_t)2 * DFF * DM * 2);
constexpr size_t WS_ROT = WS_WD2 + al((size_t)DM * DFF * 2);
constexpr size_t WS_X16 = WS_ROT + al((size_t)4097 * 64 * 8);
constexpr size_t WS_H1 = WS_X16 + al((size_t)MR * DM * 2);
constexpr size_t WS_V = WS_H1 + al((size_t)MR * DFF * 2);
constexpr size_t WS_HF = WS_V + al((size_t)MR * DM * 4);
constexpr size_t WS_H16 = WS_HF + al((size_t)MR * DM * 4);
constexpr size_t SZ_P16 = al((size_t)MR * 512 * 2);
constexpr size_t WS_QA = WS_H16 + al((size_t)MR * DM * 2);
constexpr size_t WS_KA = WS_QA + SZ_P16, WS_VA = WS_KA + SZ_P16, WS_QI = WS_VA + SZ_P16, WS_QR = WS_QI + SZ_P16, WS_KR = WS_QR + SZ_P16, WS_VR = WS_KR + SZ_P16, WS_GR = WS_VR + SZ_P16;
constexpr size_t WS_KI = WS_GR + SZ_P16;
constexpr size_t WS_WI = WS_KI + al((size_t)MR * 64 * 2);
constexpr size_t WS_MIX = WS_WI + al((size_t)MR * 8 * 4);
constexpr size_t WS_KVC = WS_MIX + al((size_t)MR * DM * 2);
constexpr size_t WS_SC = WS_KVC + al((size_t)NB * HR * 32 * 16384 * 4);
constexpr size_t WS_END = WS_SC + al((size_t)NB * HR * 32 * 16384 * 4);

constexpr int CW_TMO = 0, CW_CODE = 1, CW_BAR = 4096;

constexpr int RING_BYTES = 131072;
constexpr int LDS_BYTES = 147456;
constexpr int LDSCTL_OFF = LDS_BYTES - 512, MISC_OFF = LDSCTL_OFF + 320;
constexpr int WORK_BYTES = LDSCTL_OFF;
constexpr int NWAVES = 8, NTHR = 512;

__device__ __forceinline__ unsigned pkh(float a, float b) { f32x2 v = {a, b}; f16x2 h = __builtin_convertvector(v, f16x2); return __builtin_bit_cast(unsigned, h); }
__device__ __forceinline__ h16 f2h(float a) { _Float16 h = (_Float16)a; return __builtin_bit_cast(h16, h); }
__device__ __forceinline__ float h2f(h16 a) { return (float)__builtin_bit_cast(_Float16, a); }
__device__ __forceinline__ float hlo(unsigned w) { return h2f((h16)(w & 0xffffu)); }
__device__ __forceinline__ float hhi(unsigned w) { return h2f((h16)(w >> 16)); }
#define LDS_WAIT() asm volatile("s_waitcnt lgkmcnt(0)" ::: "memory")
#define VM_WAIT() asm volatile("s_waitcnt vmcnt(0)" ::: "memory")
__device__ __forceinline__ float wave_sum(float v) {
#pragma unroll
    for (int o = 1; o < 64; o <<= 1) v += __shfl_xor(v, o);
    return v;
}
__device__ __forceinline__ float wave_max(float v) {
#pragma unroll
    for (int o = 1; o < 64; o <<= 1) v = fmaxf(v, __shfl_xor(v, o));
    return v;
}
__device__ __forceinline__ float silu_f(float g) { return g * __builtin_amdgcn_rcpf(1.0f + __builtin_amdgcn_exp2f(-1.4426950408889634f * g)); }

namespace pg8 {
constexpr int BM = 256, BK = 64, HALF = 128, HTB = HALF * BK * 2, STAGE_BYTES = 8 * HTB, NXCD = 8, WGM = 8;
__host__ __device__ __forceinline__ int lds_byte(int r, int c) { const int st = (r >> 4) * 2 + (c >> 5), rr = r & 15, cc = c & 31, ob = rr * 64 + cc * 2; return st * 1024 + (ob ^ (((ob >> 9) & 1) << 5)); }
__host__ __device__ __forceinline__ void stage_rc(int b, int& R, int& C) { const int st = b / 1024, sb = b % 1024, swz = sb ^ (((sb >> 9) & 1) << 5); R = (st >> 1) * 16 + swz / 64; C = (st & 1) * 32 + (swz % 64) / 2; }
__host__ __device__ __forceinline__ int perm32(int rho) { const int n = rho >> 4, i = rho & 15; return 8 * (i >> 2) + 4 * n + (i & 3); }
struct Unit { int pm, pn; };
struct Gemm { const h16* A; const h16* Bt; int M, N, K; };
struct StaticOrder {
    int nM, nN, nwg, G, c;
    __host__ __device__ void init(int M, int N, int G_, int c_) { nM = M / BM; nN = N / BM; nwg = nM * nN; G = G_; c = c_; }
    __host__ __device__ bool next(int i, Unit& u) const {
        const long L = (long)i * G + c; if (L >= nwg) return false;
        int wgid = (int)L; { const int q = nwg / NXCD, r = nwg % NXCD, xcd = wgid % NXCD, off = wgid / NXCD; wgid = (xcd < r ? xcd * (q + 1) : r * (q + 1) + (xcd - r) * q) + off; }
        const int nig = WGM * nN, gid = wgid / nig, fm = gid * WGM, gsz = (nM - fm) < WGM ? (nM - fm) : WGM;
        u.pm = fm + ((wgid % nig) % gsz); u.pn = (wgid % nig) / gsz; return true;
    }
    __device__ __forceinline__ void a_ready(const Unit&) const {}
    __device__ __forceinline__ void done(const Unit&) const {}
};

struct EpiSwiglu {
    static constexpr bool PERM = true, AFTER_DRAIN = false;
    h16* O; int ldc;
    __device__ __forceinline__ void operator()(const f32x4 (&acc)[2][2][4][2], const Unit& u, int wr, int wc, int fr, int fq) const {
        const int row0 = u.pm * BM + wr * 64 + fr; const int col0 = u.pn * HALF + wc * 32 + 8 * fq;
#pragma unroll
        for (int ai = 0; ai < 2; ++ai)
#pragma unroll
            for (int m = 0; m < 4; ++m) {
                h16* rowp = O + (size_t)(row0 + ai * HALF + m * 16) * ldc + col0;
                const f32x4 g0 = acc[ai][0][m][0], g1 = acc[ai][0][m][1], u0 = acc[ai][1][m][0], u1 = acc[ai][1][m][1];
                u32x4 w;
                w.x = pkh(silu_f(g0[0]) * u0[0], silu_f(g0[1]) * u0[1]); w.y = pkh(silu_f(g0[2]) * u0[2], silu_f(g0[3]) * u0[3]);
                w.z = pkh(silu_f(g1[0]) * u1[0], silu_f(g1[1]) * u1[1]); w.w = pkh(silu_f(g1[2]) * u1[2], silu_f(g1[3]) * u1[3]);
                *(u32x4*)rowp = w;
            }
    }
};
struct EpiResid {
    static constexpr bool PERM = false, AFTER_DRAIN = false;
    const float* base; float* out; int ldc; float alpha, s;
    __device__ __forceinline__ void operator()(const f32x4 (&acc)[2][2][4][2], const Unit& u, int wr, int wc, int fr, int fq) const {
        const int col0 = u.pn * BM + wc * 32 + 4 * fq;
#pragma unroll
        for (int ai = 0; ai < 2; ++ai)
#pragma unroll
            for (int m = 0; m < 4; ++m) { const size_t off = (size_t)(u.pm * BM + ai * HALF + wr * 64 + m * 16 + fr) * ldc + col0;
#pragma unroll
                for (int bj = 0; bj < 2; ++bj)
#pragma unroll
                    for (int n = 0; n < 2; ++n) { const f32x4 bs = *(const f32x4*)(base + off + bj * HALF + n * 16); *(f32x4*)(out + off + bj * HALF + n * 16) = bs * alpha + acc[ai][bj][m][n] * s; } }
    }
};
struct EpiWin {
    static constexpr bool PERM = true, AFTER_DRAIN = false;
    h16* p16base; size_t p16stride;
    h16* ki16; float* wi;
    float* dout;
    __device__ __forceinline__ void operator()(const f32x4 (&acc)[2][2][4][2], const Unit& u, int wr, int wc, int fr, int fq) const {
        const int row0 = u.pm * BM + wr * 64 + fr;
        if (u.pn < 16) {
            const int seg = u.pn >> 1; h16* base = p16base + (size_t)seg * p16stride; const int colt = (u.pn & 1) * 256 + wc * 32 + 8 * fq;
            float* o32 = nullptr; float* o32s = nullptr;
            if (seg == 1) { o32 = dout + O_KP; o32s = dout + O_KS; } else if (seg == 2) { o32 = dout + O_VP; o32s = dout + O_VS; }
#pragma unroll
            for (int ai = 0; ai < 2; ++ai)
#pragma unroll
                for (int m = 0; m < 4; ++m) { const int row = row0 + ai * HALF + m * 16;
#pragma unroll
                    for (int bj = 0; bj < 2; ++bj) { const f32x4 v0 = acc[ai][bj][m][0], v1 = acc[ai][bj][m][1]; const int col = colt + bj * HALF;
                        u32x4 w; w.x = pkh(v0[0], v0[1]); w.y = pkh(v0[2], v0[3]); w.z = pkh(v1[0], v1[1]); w.w = pkh(v1[2], v1[3]);
                        *(u32x4*)(base + (size_t)row * 512 + col) = w;
                        if (o32) { float* d = nullptr; if (row < MP) d = o32 + (size_t)row * 512 + col; else if (row < MV) d = o32s + (size_t)(row - MP) * 512 + col;
                            if (d) { *(f32x4*)d = v0; *(f32x4*)(d + 4) = v1; } } } }
        } else {
#pragma unroll
            for (int ai = 0; ai < 2; ++ai)
#pragma unroll
                for (int m = 0; m < 4; ++m) { const int row = row0 + ai * HALF + m * 16; const f32x4 v0 = acc[ai][0][m][0], v1 = acc[ai][0][m][1];
                    if (wc < 2) { const int col = wc * 32 + 8 * fq;
                        u32x4 w; w.x = pkh(v0[0], v0[1]); w.y = pkh(v0[2], v0[3]); w.z = pkh(v1[0], v1[1]); w.w = pkh(v1[2], v1[3]);
                        *(u32x4*)(ki16 + (size_t)row * 64 + col) = w;
                        float* d = nullptr; if (row < MP) d = dout + O_KIP + (size_t)row * 64 + col; else if (row < MV) d = dout + O_KIS + (size_t)(row - MP) * 64 + col;
                        if (d) { *(f32x4*)d = v0; *(f32x4*)(d + 4) = v1; }
                    } else if (wc == 2 && fq == 0) { *(f32x4*)(wi + (size_t)row * 8) = v0; *(f32x4*)(wi + (size_t)row * 8 + 4) = v1; } }
        }
    }
};

template <class Epi, class Sched, bool ALIGN_EPI = false>
__device__ __forceinline__ void gemm_phase(LAS unsigned char* lds, const Gemm g, const Sched& S, const Epi& E) {
    const int tid = threadIdx.x, wid = __builtin_amdgcn_readfirstlane(tid >> 6), lane = tid & 63, wr = wid >> 2, wc = wid & 3, fr = lane & 15, fq = lane >> 4;
    const int K = g.K, nt = K / BK;
    unsigned voffA[2], voffB[2];
#pragma unroll
    for (int i = 0; i < 2; ++i) { int R, C; stage_rc(tid * 16 + i * 8192, R, C); const int Rb = Epi::PERM ? ((R & ~31) + perm32(R & 31)) : R;
        voffA[i] = (unsigned)(R * K + C) * 2u; voffB[i] = (unsigned)(Rb * K + C) * 2u; }
    const size_t kstep = (size_t)(BK * 2);
    const size_t hstep = (size_t)HALF * K * 2;
    const size_t tstep = 2 * hstep;
    const unsigned ldsw = (unsigned)wid * 1024u;
    const int aoff = lds_byte(wr * 64 + fr, fq * 8), boff = lds_byte(wc * 32 + fr, fq * 8);
#define PG8_SA(b, h) (((b) * 2 + (h)) * HTB)
#define PG8_SB(b, h) ((4 + (b) * 2 + (h)) * HTB)
#define PG8_STAGE(bufoff, gbase, voff) do { _Pragma("unroll") for (int _i = 0; _i < 2; ++_i) \
        __builtin_amdgcn_global_load_lds((const unsigned*)((const char*)(gbase) + (voff)[_i]), (LAS unsigned*)(lds + (bufoff) + ldsw + _i * 8192), 16, 0, 0); } while (0)
#define PG8_LDA(dst, b, h) do { _Pragma("unroll") for (int m = 0; m < 4; ++m) _Pragma("unroll") for (int k = 0; k < 2; ++k) dst[m][k] = *(const LAS s16x8*)(lds + PG8_SA(b, h) + aoff + m * 2048 + k * 1024); } while (0)
#define PG8_LDB(dst, b, h) do { _Pragma("unroll") for (int n = 0; n < 2; ++n) _Pragma("unroll") for (int k = 0; k < 2; ++k) dst[n][k] = *(const LAS s16x8*)(lds + PG8_SB(b, h) + boff + n * 2048 + k * 1024); } while (0)
#define PG8_MMA(ai, bj, At, Bt) do { __builtin_amdgcn_s_setprio(1); _Pragma("unroll") for (int m = 0; m < 4; ++m) _Pragma("unroll") for (int n = 0; n < 2; ++n) _Pragma("unroll") for (int k = 0; k < 2; ++k) \
        acc[ai][bj][m][n] = __builtin_amdgcn_mfma_f32_16x16x32_f16(__builtin_bit_cast(f16x8, Bt[n][k]), __builtin_bit_cast(f16x8, At[m][k]), acc[ai][bj][m][n], 0, 0, 0); __builtin_amdgcn_s_setprio(0); } while (0)
#define PG8_WAIT_V(n) asm volatile("s_waitcnt vmcnt(" #n ")" ::: "memory")
#define PG8_WAIT_L(n) asm volatile("s_waitcnt lgkmcnt(" #n ")" ::: "memory")
#define PG8_BAR __builtin_amdgcn_s_barrier()
#define PG8_SCHED __builtin_amdgcn_sched_barrier(0)
    Unit cur, nxt; int ui = 0;
    if (!S.next(0, cur)) return;
    f32x4 acc[2][2][4][2];
#pragma unroll
    for (int a = 0; a < 2; ++a)
#pragma unroll
        for (int b = 0; b < 2; ++b)
#pragma unroll
            for (int m = 0; m < 4; ++m)
#pragma unroll
                for (int n = 0; n < 2; ++n) acc[a][b][m][n] = (f32x4){0.f, 0.f, 0.f, 0.f};
    s16x8 At[4][2], B0[2][2], B1[2][2];
    const char* cA = (const char*)g.A + (size_t)cur.pm * tstep; const char* cB = (const char*)g.Bt + (size_t)cur.pn * tstep;
    S.a_ready(cur);
    PG8_STAGE(PG8_SB(0, 0), cB, voffB); PG8_STAGE(PG8_SB(0, 1), cB + hstep, voffB); PG8_STAGE(PG8_SA(0, 0), cA, voffA); PG8_STAGE(PG8_SA(0, 1), cA + hstep, voffA);
    if (wr == 1) PG8_BAR;
    PG8_WAIT_V(2); PG8_BAR;
    PG8_STAGE(PG8_SB(1, 0), cB + kstep, voffB); PG8_STAGE(PG8_SA(1, 0), cA + kstep, voffA); PG8_STAGE(PG8_SB(1, 1), cB + hstep + kstep, voffB);
    PG8_WAIT_V(6); PG8_BAR;
    for (;;) {
        const bool has_next = S.next(ui + 1, nxt);
        const char* nA = has_next ? (const char*)g.A + (size_t)nxt.pm * tstep : cA; const char* nB = has_next ? (const char*)g.Bt + (size_t)nxt.pn * tstep : cB;
        for (int t = 0; t < nt; t += 2) {
            const bool last = (t == nt - 2);
            const char* a1 = cA + (size_t)(t + 1) * kstep;
            const char* a2 = last ? nA : cA + (size_t)(t + 2) * kstep; const char* b2 = last ? nB : cB + (size_t)(t + 2) * kstep;
            const char* a3 = a2 + kstep; const char* b3 = b2 + kstep;
            if (last && has_next) S.a_ready(nxt);
            PG8_LDB(B0, 0, 0); PG8_LDB(B1, 0, 1); PG8_SCHED; PG8_LDA(At, 0, 0); PG8_STAGE(PG8_SA(1, 1), a1 + hstep, voffA);
            PG8_WAIT_V(8); PG8_WAIT_L(0); PG8_BAR; PG8_MMA(0, 0, At, B0); PG8_MMA(0, 1, At, B1); PG8_BAR; PG8_SCHED;
            PG8_LDA(At, 0, 1); PG8_STAGE(PG8_SB(0, 0), b2, voffB); PG8_STAGE(PG8_SB(0, 1), b2 + hstep, voffB); PG8_STAGE(PG8_SA(0, 0), a2, voffA);
            PG8_WAIT_V(8); PG8_WAIT_L(0); PG8_BAR; PG8_MMA(1, 0, At, B0); PG8_MMA(1, 1, At, B1); PG8_BAR; PG8_SCHED;
            PG8_LDB(B0, 1, 0); PG8_LDB(B1, 1, 1); PG8_SCHED; PG8_LDA(At, 1, 0); PG8_STAGE(PG8_SA(0, 1), a2 + hstep, voffA);
            PG8_WAIT_V(8); PG8_WAIT_L(0); PG8_BAR; PG8_MMA(0, 0, At, B0); PG8_MMA(0, 1, At, B1); PG8_BAR; PG8_SCHED;
            PG8_LDA(At, 1, 1); PG8_STAGE(PG8_SB(1, 0), b3, voffB); PG8_STAGE(PG8_SB(1, 1), b3 + hstep, voffB); PG8_STAGE(PG8_SA(1, 0), a3, voffA);
            PG8_WAIT_V(8); PG8_WAIT_L(0); PG8_BAR; PG8_MMA(1, 0, At, B0); PG8_MMA(1, 1, At, B1); PG8_BAR; PG8_SCHED;
        }
        if constexpr (ALIGN_EPI) { if (wr == 0) PG8_BAR; }
        E(acc, cur, wr, wc, fr, fq); S.done(cur);
        if (!has_next) break;
#pragma unroll
        for (int a = 0; a < 2; ++a)
#pragma unroll
            for (int b = 0; b < 2; ++b)
#pragma unroll
                for (int m = 0; m < 4; ++m)
#pragma unroll
                    for (int n = 0; n < 2; ++n) acc[a][b][m][n] = (f32x4){0.f, 0.f, 0.f, 0.f};
        cur = nxt; cA = nA; cB = nB; ++ui;
        if constexpr (ALIGN_EPI) { if (wr == 1) PG8_BAR; }
    }
    PG8_WAIT_V(0);
    if constexpr (!ALIGN_EPI) { if (wr == 0) PG8_BAR; }
    PG8_BAR;
#undef PG8_SA
#undef PG8_SB
#undef PG8_STAGE
#undef PG8_LDA
#undef PG8_LDB
#undef PG8_MMA
#undef PG8_WAIT_V
#undef PG8_WAIT_L
#undef PG8_BAR
#undef PG8_SCHED
}
}

#define XB_TMO      128
#define XB_XCNT(j)  (256  + 64 * (j))
#define XB_XSUB(j)  (1280 + 64 * (j))
#define XB_XGEN(j)  (2304 + 64 * (j))
#define XB_TOP      3328
#define XB_TOPGEN   3392
#define XCD_BAR_WORDS 3456
#define XB_SPIN_CAP (1u << 18)

__device__ __forceinline__ unsigned xb_ld(unsigned* p)              { return __hip_atomic_load(p, __ATOMIC_RELAXED, __HIP_MEMORY_SCOPE_AGENT); }
__device__ __forceinline__ unsigned xb_add(unsigned* p, unsigned v) { return __hip_atomic_fetch_add(p, v, __ATOMIC_RELAXED, __HIP_MEMORY_SCOPE_AGENT); }
__device__ __forceinline__ unsigned xb_xcc_id() { return (unsigned)__builtin_amdgcn_s_getreg((3 << 11) | 20) & 0xFu; }
#define XB_SPIN(cond, bar) do { unsigned _sp = 0; while (cond) { __builtin_amdgcn_s_sleep(1); \
    if ((++_sp & 255u) == 0u) { if (xb_ld(&(bar)[XB_TMO])) break; if (_sp > XB_SPIN_CAP) { atomicAdd(&(bar)[XB_TMO], 1u); break; } } } } while (0)

struct XcdBarrier {
    unsigned* bar; unsigned x;
    volatile LAS unsigned* st;
};

__device__ __forceinline__ XcdBarrier xcd_barrier_post(unsigned* bar, volatile LAS unsigned* st) {
    XcdBarrier b; b.bar = bar; b.x = xb_xcc_id(); b.st = st;
    if (threadIdx.x == 0) (void)xb_add(&bar[XB_XCNT(b.x)], 1u);
    return b;
}
__device__ __forceinline__ void xcd_barrier_complete(unsigned* bar, unsigned x, unsigned& nloc, unsigned& nx) {
    const unsigned G = gridDim.x * gridDim.y * gridDim.z;
    unsigned sum, cnt, mine, sp = 0u;
    for (;;) {
        sum = 0u; cnt = 0u; mine = 0u;
#pragma unroll
        for (unsigned j = 0; j < 16; ++j) { const unsigned c = xb_ld(&bar[XB_XCNT(j)]); sum += c; cnt += (c > 0u) ? 1u : 0u; mine = (j == x) ? c : mine; }
        if (sum == G) break;
        __builtin_amdgcn_s_sleep(1);
        if ((++sp & 255u) == 0u) { if (xb_ld(&bar[XB_TMO])) break; if (sp > XB_SPIN_CAP) { atomicAdd(&bar[XB_TMO], 1u); break; } }
    }
    nloc = mine > 0u ? mine : 1u; nx = cnt > 0u ? cnt : 1u;
}

__device__ __forceinline__ void xcd_barrier(const XcdBarrier& b) {
    asm volatile("s_waitcnt vmcnt(0)" ::: "memory");
    __syncthreads();
    if (threadIdx.x == 0) {
        unsigned* bar = b.bar;
        __builtin_amdgcn_s_waitcnt(0);
        unsigned nloc = b.st[0], nx = b.st[1];
        if (nloc == 0u) { xcd_barrier_complete(bar, b.x, nloc, nx); b.st[0] = nloc; b.st[1] = nx; }
        const unsigned old = xb_add(&bar[XB_XSUB(b.x)], 1u);
        const unsigned gen = old / nloc;
        if (old + 1u == (gen + 1u) * nloc) {
            __builtin_amdgcn_fence(__ATOMIC_RELEASE, "agent");
            asm volatile("s_waitcnt vmcnt(0)" ::: "memory");
            const unsigned og = xb_add(&bar[XB_TOP], 1u);
            const unsigned tg = og / nx;
            if (og + 1u == (tg + 1u) * nx) xb_add(&bar[XB_TOPGEN], 1u);
            else XB_SPIN(xb_ld(&bar[XB_TOPGEN]) == tg, bar);
            __builtin_amdgcn_fence(__ATOMIC_ACQUIRE, "agent");
            xb_add(&bar[XB_XGEN(b.x)], 1u);
            asm volatile("s_waitcnt vmcnt(0)" ::: "memory");
        } else {
            XB_SPIN(xb_ld(&bar[XB_XGEN(b.x)]) == gen, bar);
            __builtin_amdgcn_fence(__ATOMIC_ACQUIRE, "agent");
            asm volatile("s_waitcnt vmcnt(0)" ::: "memory");
        }
    }
    __syncthreads();
}

struct Args { const float* in[23]; const int* page_table; float* out; unsigned char* ws; int ph_lo, ph_hi; };
struct Frame {
    LAS unsigned char* lds;
    int tid, lane, wave, vcu, G;
};

__device__ __forceinline__ void p0_transpose_item(const float* W, int K, int N, int src0, int nvalid, h16* WT, int dst0, int kb, LAS float* scr, int lane) {
    const int k0 = 64 * kb;
#pragma unroll 8
    for (int i = 0; i < 32; ++i) { const int kk = 2 * i + (lane >> 5); const int n = lane & 31; scr[kk * 33 + n] = (n < nvalid) ? W[(size_t)(k0 + kk) * N + src0 + n] : 0.f; }
    LDS_WAIT(); asm volatile("" ::: "memory");
    const int c = lane & 7;
#pragma unroll
    for (int j = 0; j < 4; ++j) { const int n = (lane >> 3) + 8 * j; const LAS float* s = scr + (8 * c) * 33 + n;
        u32x4 o; o.x = pkh(s[0 * 33], s[1 * 33]); o.y = pkh(s[2 * 33], s[3 * 33]); o.z = pkh(s[4 * 33], s[5 * 33]); o.w = pkh(s[6 * 33], s[7 * 33]);
        *(GAS u32x4*)(WT + (size_t)(dst0 + n) * K + k0 + 8 * c) = o; }
    LDS_WAIT(); asm volatile("" ::: "memory");
}
__device__ __forceinline__ void p0_prologue(const Frame& F, const Args& a) {
    unsigned char* ws = a.ws;
    LAS float* scr = (LAS float*)(F.lds + F.wave * 16384);
    const int gw = F.vcu * NWAVES + F.wave, NGW = F.G * NWAVES;
    constexpr int I_G = 16 * 88, I_D = 44 * 32, I_IN = 16 * 136, I_O = 16 * 32;
    constexpr int NITEMS = 4 * I_G + 2 * I_D + I_IN + I_O;
    for (int it = gw; it < NITEMS; it += NGW) {
        int r = it;
        if (r < 4 * I_G) { const int which = r / I_G; r %= I_G; const int kb = r / 88, nb = r % 88, n0 = nb * 32;
            const float* W = a.in[which == 0 ? 8 : which == 1 ? 9 : which == 2 ? 18 : 19]; h16* WT = (h16*)(ws + (which < 2 ? WS_WGU1 : WS_WGU2));
            const int dst = (n0 / 128) * 256 + (n0 % 128) + ((which & 1) ? 128 : 0);
            p0_transpose_item(W, DM, DFF, n0, 32, WT, dst, kb, scr, F.lane); continue; }
        r -= 4 * I_G;
        if (r < 2 * I_D) { const int which = r / I_D; r %= I_D; const int kb = r / 32, nb = r % 32;
            p0_transpose_item(a.in[which == 0 ? 10 : 20], DFF, DM, nb * 32, 32, (h16*)(ws + (which == 0 ? WS_WD1 : WS_WD2)), nb * 32, kb, scr, F.lane); continue; }
        r -= 2 * I_D;
        if (r < I_IN) { const int kb = r / 136, d = r % 136; int src, nv;
            if (d < 64) { src = 32 * d; nv = 32; } else if (d < 128) { src = C_QR + 32 * (d - 64); nv = 32; } else if (d < 130) { src = C_KI + 32 * (d - 128); nv = 32; } else if (d == 130) { src = C_WI; nv = 8; } else { src = 0; nv = 0; }
            p0_transpose_item(a.in[13], DM, NIN, src, nv, (h16*)(ws + WS_WIN), 32 * d, kb, scr, F.lane); continue; }
        r -= I_IN;
        { const int kb = r / 32, nb = r % 32; p0_transpose_item(a.in[15], DM, DM, nb * 32, 32, (h16*)(ws + WS_WOUT), nb * 32, kb, scr, F.lane); }
    }
    h16* X16 = (h16*)(ws + WS_X16);
    for (int m = gw; m < MR; m += NGW) {
        const float* src = (m < MP) ? a.in[0] + (size_t)m * DM : (m < MV ? a.in[1] + (size_t)(m - MP) * DM : nullptr);
        GAS u32x2* o = (GAS u32x2*)(X16 + (size_t)m * DM) + F.lane;
#pragma unroll
        for (int j = 0; j < 4; ++j) { f32x4 v = src ? ((const GAS f32x4*)src)[F.lane + 64 * j] : (f32x4){0.f, 0.f, 0.f, 0.f}; u32x2 w; w.x = pkh(v[0], v[1]); w.y = pkh(v[2], v[3]); o[64 * j] = w; }
    }
    { float* hf = (float*)(ws + WS_HF); const size_t n4 = (size_t)MR * DM / 4;
      for (size_t i = (size_t)F.vcu * NTHR + F.tid; i < n4; i += (size_t)F.G * NTHR) { const size_t e = i * 4; f32x4 v = (f32x4){0.f, 0.f, 0.f, 0.f};
          if (e < (size_t)MP * DM) v = *(const GAS f32x4*)(a.in[0] + e); else if (e < (size_t)MV * DM) v = *(const GAS f32x4*)(a.in[1] + (e - (size_t)MP * DM));
          *(GAS f32x4*)(hf + e) = v; } }
    f32x2* ROT = (f32x2*)(ws + WS_ROT);
    for (int e = (F.vcu * NTHR + F.tid); e < 4097 * 64; e += F.G * NTHR) {
        const int p = e >> 6, i = e & 63; const float pos = (p < 4096) ? (float)p : 8192.f;
        const float freq = powf(10000.f, -(float)i / 64.f); const float ang = pos * freq;
        ROT[e] = (f32x2){cosf(ang), sinf(ang)};
    }
}

__device__ __forceinline__ void ln_rows(const Frame& F, const float* V, const float* g, const float* b, float* o32, h16* o16, int nrows) {
    const int gw = F.vcu * NWAVES + F.wave, NGW = F.G * NWAVES;
    f32x4 gv[4], bv[4];
#pragma unroll
    for (int j = 0; j < 4; ++j) { gv[j] = ((const GAS f32x4*)g)[F.lane + 64 * j]; bv[j] = ((const GAS f32x4*)b)[F.lane + 64 * j]; }
    for (int m = gw; m < nrows; m += NGW) {
        const GAS f32x4* xr = (const GAS f32x4*)(V + (size_t)m * DM) + F.lane;
        f32x4 v[4]; float s = 0.f;
#pragma unroll
        for (int j = 0; j < 4; ++j) { v[j] = xr[64 * j]; s += (v[j][0] + v[j][1]) + (v[j][2] + v[j][3]); }
        const float mean = wave_sum(s) * (1.f / DM); float s2 = 0.f;
#pragma unroll
        for (int j = 0; j < 4; ++j) { v[j] = v[j] - mean; s2 += (v[j][0] * v[j][0] + v[j][1] * v[j][1]) + (v[j][2] * v[j][2] + v[j][3] * v[j][3]); }
        const float rstd = 1.f / sqrtf(wave_sum(s2) * (1.f / DM) + LN_EPS);
#pragma unroll
        for (int j = 0; j < 4; ++j) { const f32x4 y = v[j] * rstd * gv[j] + bv[j];
            if (o32) ((GAS f32x4*)(o32 + (size_t)m * DM))[F.lane + 64 * j] = y;
            if (o16) { u32x2 w; w.x = pkh(y[0], y[1]); w.y = pkh(y[2], y[3]); ((GAS u32x2*)(o16 + (size_t)m * DM))[F.lane + 64 * j] = w; } }
    }
}

__device__ __forceinline__ int t5_bucket(int n) {
    if (n < 16) return n < 0 ? 0 : n;
    if (n >= 113) return 31;
    const int v = 16 + (int)(log2f((float)n * 0.0625f) * (16.0f / 3.0f));
    return v > 31 ? 31 : v;
}
__device__ __forceinline__ unsigned f2key(float x) { if (x == 0.f) x = 0.f; const unsigned u = __float_as_uint(x); return (u & 0x80000000u) ? ~u : (u | 0x80000000u); }

constexpr int QL_SC = 0;
constexpr int QL_HIST = 32832;
constexpr int QL_LIST = QL_HIST + 1024;
constexpr int QL_PHYS = QL_LIST + 1024;
constexpr int QL_LG = QL_PHYS + 1024;
constexpr int QL_QI = QL_LG + 8192;
constexpr int QL_QA = QL_QI + 2048;
constexpr int QL_BIAS = QL_QA + 2176;
constexpr int QL_MISC = QL_BIAS + 1024;
constexpr int QL_SCAN = QL_MISC + 256;
constexpr int QL_END = QL_SCAN + 2048;
static_assert(QL_END <= RING_BYTES, "query phase LDS");

template <bool SAMPLE>
__device__ __forceinline__ void sparse_query(const Frame& F, const Args& a, int qi  ) {
    unsigned char* ws = a.ws;
    LAS float* sc = (LAS float*)(F.lds + QL_SC); LAS unsigned* key = (LAS unsigned*)(F.lds + QL_SC);
    LAS unsigned* hist = (LAS unsigned*)(F.lds + QL_HIST); LAS int* list = (LAS int*)(F.lds + QL_LIST); LAS int* phys = (LAS int*)(F.lds + QL_PHYS);
    LAS float* lg = (LAS float*)(F.lds + QL_LG); LAS float* qis = (LAS float*)(F.lds + QL_QI); LAS float* qas = (LAS float*)(F.lds + QL_QA);
    LAS float* bias = (LAS float*)(F.lds + QL_BIAS); LAS unsigned* misc = (LAS unsigned*)(F.lds + QL_MISC); LAS int* scan = (LAS int*)(F.lds + QL_SCAN);
    const int tid = F.tid, lane = F.lane, wave = F.wave;
    const int row = SAMPLE ? MP + qi : qi;
    const int bb = SAMPLE ? qi : qi / SEQ, t = SAMPLE ? PAST : qi % SEQ;
    const int n = t + 1;
    const h16* QA = (const h16*)(ws + WS_QA); const h16* KA = (const h16*)(ws + WS_KA); const h16* VA = (const h16*)(ws + WS_VA);
    const h16* QI = (const h16*)(ws + WS_QI); const h16* KI = (const h16*)(ws + WS_KI); const float* WI = (const float*)(ws + WS_WI);
    const int* pt = a.page_table + bb * NPAGES;
    { const int h = tid >> 6, d = tid & 63;
      qis[d * 8 + h] = h2f(QI[(size_t)row * 512 + tid]) * 0.125f;
      qas[h * 68 + d] = h2f(QA[(size_t)row * 512 + tid]);
      if (tid < 256) bias[tid] = a.in[7][tid];
      if (tid < 8) ((LAS float*)misc)[32 + tid] = WI[(size_t)row * 8 + tid] * 0.35355339059327373f;
      if (tid == 0) misc[2] = 0u; }
    __syncthreads();
    int cnt;
    if (n > TOPK) {
        float wv[8];
#pragma unroll
        for (int h = 0; h < 8; ++h) wv[h] = ((LAS float*)misc)[32 + h];
        for (int s = tid; s < n; s += NTHR) {
            float acc[8];
#pragma unroll
            for (int h = 0; h < 8; ++h) acc[h] = 0.f;
            if (!SAMPLE || s == PAST) {
                const h16* kp = SAMPLE ? KI + (size_t)row * 64 : KI + (size_t)(bb * SEQ + s) * 64;
#pragma unroll
                for (int c = 0; c < 8; ++c) { const u32x4 w = *(const GAS u32x4*)(kp + 8 * c);
#pragma unroll
                    for (int e = 0; e < 4; ++e) { const unsigned ww = w[e]; const float k0 = hlo(ww), k1 = hhi(ww); const int d = 8 * c + 2 * e;
                        const f32x4 qa0 = *(const LAS f32x4*)(qis + d * 8), qa1 = *(const LAS f32x4*)(qis + d * 8 + 4), qb0 = *(const LAS f32x4*)(qis + d * 8 + 8), qb1 = *(const LAS f32x4*)(qis + d * 8 + 12);
                        acc[0] += qa0[0] * k0; acc[1] += qa0[1] * k0; acc[2] += qa0[2] * k0; acc[3] += qa0[3] * k0; acc[4] += qa1[0] * k0; acc[5] += qa1[1] * k0; acc[6] += qa1[2] * k0; acc[7] += qa1[3] * k0;
                        acc[0] += qb0[0] * k1; acc[1] += qb0[1] * k1; acc[2] += qb0[2] * k1; acc[3] += qb0[3] * k1; acc[4] += qb1[0] * k1; acc[5] += qb1[1] * k1; acc[6] += qb1[2] * k1; acc[7] += qb1[3] * k1; } }
            } else {
                const float* kp = a.in[4] + ((size_t)pt[s >> 7] * PAGE + (s & 127)) * 64;
#pragma unroll 4
                for (int c = 0; c < 16; ++c) { const f32x4 kv = *(const GAS f32x4*)(kp + 4 * c);
#pragma unroll
                    for (int e = 0; e < 4; ++e) { const float k0 = kv[e]; const int d = 4 * c + e;
                        const f32x4 qa0 = *(const LAS f32x4*)(qis + d * 8), qa1 = *(const LAS f32x4*)(qis + d * 8 + 4);
                        acc[0] += qa0[0] * k0; acc[1] += qa0[1] * k0; acc[2] += qa0[2] * k0; acc[3] += qa0[3] * k0; acc[4] += qa1[0] * k0; acc[5] += qa1[1] * k0; acc[6] += qa1[2] * k0; acc[7] += qa1[3] * k0; } }
            }
            float sco = 0.f;
#pragma unroll
            for (int h = 0; h < 8; ++h) sco += wv[h] * fmaxf(acc[h], 0.f);
            key[s] = f2key(sco);
        }
        __syncthreads();
        unsigned prefix = 0u; int r = TOPK;
#pragma unroll 1
        for (int pass = 0; pass < 4; ++pass) {
            const int shift = 24 - 8 * pass;
            if (tid < 256) hist[tid] = 0u;
            __syncthreads();
            for (int s = tid; s < n; s += NTHR) { const unsigned u = key[s]; if (pass == 0 || (u >> (shift + 8)) == prefix) __hip_atomic_fetch_add(hist + ((u >> shift) & 255u), 1u, __ATOMIC_RELAXED, __HIP_MEMORY_SCOPE_WORKGROUP); }
            __syncthreads();
            if (wave == 0) {
                int c[4]; int local = 0;
#pragma unroll
                for (int j = 0; j < 4; ++j) { c[j] = (int)hist[255 - (4 * lane + j)]; local += c[j]; }
                int incl = local;
#pragma unroll
                for (int o = 1; o < 64; o <<= 1) { const int v = __shfl_up(incl, o); if (lane >= o) incl += v; }
                const int excl = incl - local;
                if (excl < r && r <= incl) { int run = excl;
#pragma unroll
                    for (int j = 0; j < 4; ++j) { if (run < r && r <= run + c[j]) { misc[0] = (unsigned)(255 - (4 * lane + j)); misc[1] = (unsigned)(r - run); } run += c[j]; } }
            }
            __syncthreads();
            prefix = (prefix << 8) | misc[0]; r = (int)misc[1];
            __syncthreads();
        }
        const int chunk = (n + NTHR - 1) / NTHR; const int s0 = tid * chunk, s1 = (s0 + chunk < n) ? s0 + chunk : n;
        int neq = 0;
        for (int s = s0; s < s1; ++s) neq += (key[s] == prefix) ? 1 : 0;
        int incl = neq;
#pragma unroll
        for (int o = 1; o < 64; o <<= 1) { const int v = __shfl_up(incl, o); if (lane >= o) incl += v; }
        if (lane == 63) misc[16 + wave] = (unsigned)incl;
        __syncthreads();
        int ord = incl - neq;
        for (int w = 0; w < wave; ++w) ord += (int)misc[16 + w];
        for (int s = s0; s < s1; ++s) { const unsigned u = key[s]; bool take = u > prefix; if (u == prefix) { take = ord < r; ++ord; }
            if (take) { const unsigned p = __hip_atomic_fetch_add(misc + 2, 1u, __ATOMIC_RELAXED, __HIP_MEMORY_SCOPE_WORKGROUP); if (p < TOPK) list[p] = s; } }
        __syncthreads();
        cnt = TOPK;
    } else {
        if (tid < n) list[tid] = tid;
        __syncthreads();
        cnt = n;
    }
    if (tid < cnt) { const int s = list[tid]; int pr;
        if (SAMPLE) pr = (s >= PAST) ? -1 : pt[s >> 7] * PAGE + (s & 127); else pr = bb * SEQ + s;
        phys[tid] = pr; }
    __syncthreads();
    for (int p = tid; p < cnt * 8; p += NTHR) {
        const int k = p >> 3, h = p & 7; const int pr = phys[k]; float dot = 0.f;
        if (!SAMPLE) { const h16* kp = KA + (size_t)pr * 512 + h * 64;
#pragma unroll
            for (int c = 0; c < 8; ++c) { const u32x4 w = *(const GAS u32x4*)(kp + 8 * c);
#pragma unroll
                for (int e = 0; e < 4; ++e) dot += qas[h * 68 + 8 * c + 2 * e] * hlo(w[e]) + qas[h * 68 + 8 * c + 2 * e + 1] * hhi(w[e]); }
        } else { const float* kp = (pr < 0) ? a.out + O_KS + (size_t)qi * 512 + h * 64 : a.in[2] + (size_t)pr * 512 + h * 64;
#pragma unroll 4
            for (int c = 0; c < 16; ++c) { const f32x4 kv = *(const GAS f32x4*)(kp + 4 * c);
                dot += qas[h * 68 + 4 * c] * kv[0] + qas[h * 68 + 4 * c + 1] * kv[1] + qas[h * 68 + 4 * c + 2] * kv[2] + qas[h * 68 + 4 * c + 3] * kv[3]; } }
        lg[h * 256 + k] = dot * 0.125f + bias[t5_bucket(t - list[k]) * 8 + h];
    }
    __syncthreads();
    { float v[4]; float mx = -INFINITY;
#pragma unroll
      for (int j = 0; j < 4; ++j) { const int k = lane + 64 * j; v[j] = (k < cnt) ? lg[wave * 256 + k] : -INFINITY; mx = fmaxf(mx, v[j]); }
      mx = wave_max(mx); float sm = 0.f;
#pragma unroll
      for (int j = 0; j < 4; ++j) { v[j] = (lane + 64 * j < cnt) ? __expf(v[j] - mx) : 0.f; sm += v[j]; }
      sm = wave_sum(sm); const float inv = 1.f / sm;
#pragma unroll
      for (int j = 0; j < 4; ++j) lg[wave * 256 + lane + 64 * j] = v[j] * inv; }
    __syncthreads();
    { const int h = tid >> 6; float o = 0.f;
      if (!SAMPLE) {
          int k = 0;
          for (; k + 4 <= cnt; k += 4) { const float v0 = h2f(VA[(size_t)phys[k] * 512 + tid]), v1 = h2f(VA[(size_t)phys[k + 1] * 512 + tid]), v2 = h2f(VA[(size_t)phys[k + 2] * 512 + tid]), v3 = h2f(VA[(size_t)phys[k + 3] * 512 + tid]);
              o += lg[h * 256 + k] * v0 + lg[h * 256 + k + 1] * v1 + lg[h * 256 + k + 2] * v2 + lg[h * 256 + k + 3] * v3; }
          for (; k < cnt; ++k) o += lg[h * 256 + k] * h2f(VA[(size_t)phys[k] * 512 + tid]);
      } else {
          for (int k = 0; k < cnt; ++k) { const int pr = phys[k]; const float v = (pr < 0) ? a.out[O_VS + (size_t)qi * 512 + tid] : a.in[3][(size_t)pr * 512 + tid]; o += lg[h * 256 + k] * v; }
      }
      ((h16*)(ws + WS_MIX))[(size_t)row * DM + tid] = f2h(o); }
    __syncthreads();
}

constexpr int LDP = 136;
constexpr int RT_BYTES = 128 * LDP * 2;
static_assert(4 * RT_BYTES <= WORK_BYTES, "retention LDS");
__device__ __forceinline__ void mm128(const LAS h16* A, const LAS h16* Bt, int wave, int lane, f32x4 (&acc)[8]) {
    const int r = lane & 15, q = lane >> 4;
#pragma unroll
    for (int ks = 0; ks < 4; ++ks) {
        const f16x8 av = __builtin_bit_cast(f16x8, *(const LAS s16x8*)(A + (16 * wave + r) * LDP + ks * 32 + q * 8));
#pragma unroll
        for (int nt = 0; nt < 8; ++nt) { const f16x8 bv = __builtin_bit_cast(f16x8, *(const LAS s16x8*)(Bt + (16 * nt + r) * LDP + ks * 32 + q * 8));
            acc[nt] = __builtin_amdgcn_mfma_f32_16x16x32_f16(av, bv, acc[nt], 0, 0, 0); }
    }
}
__device__ __forceinline__ float gamma_log2(int h) { return log2f(1.0f - exp2f(-5.0f - (float)h)); }
template <bool TRANS>
__device__ __forceinline__ void load_rot(const Frame& F, const h16* src  , const f32x2* rot  , LAS h16* dst, float scale, float lg2, int decay_mode  ) {
    for (int e = F.tid; e < 128 * 64; e += NTHR) { const int j = e >> 6, i = e & 63;
        const float x1 = h2f(src[(size_t)j * 512 + i]), x2 = h2f(src[(size_t)j * 512 + 64 + i]); const f32x2 cs = rot[j * 64 + i];
        float sc = scale; if (decay_mode == 1) sc *= exp2f((float)(127 - j) * lg2);
        const float o1 = (x1 * cs[0] - x2 * cs[1]) * sc, o2 = (x1 * cs[1] + x2 * cs[0]) * sc;
        if (TRANS) { dst[i * LDP + j] = f2h(o1); dst[(64 + i) * LDP + j] = f2h(o2); } else { dst[j * LDP + i] = f2h(o1); dst[j * LDP + 64 + i] = f2h(o2); } }
}
__device__ __forceinline__ void ret_kv_unit(const Frame& F, const Args& a, int unit) {
    unsigned char* ws = a.ws; const int c = unit & 31, h = (unit >> 5) & 3, b = unit >> 7;
    LAS h16* Kt = (LAS h16*)(F.lds); LAS h16* Vt = (LAS h16*)(F.lds + RT_BYTES);
    const size_t row0 = (size_t)b * SEQ + c * 128; const float lg2 = gamma_log2(h);
    load_rot<true>(F, (const h16*)(ws + WS_KR) + row0 * 512 + h * 128, (const f32x2*)(ws + WS_ROT) + (size_t)(c * 128) * 64, Kt, 0.08838834764831845f, lg2, 1);
    const h16* V = (const h16*)(ws + WS_VR) + row0 * 512 + h * 128;
    for (int e = F.tid; e < 128 * 128; e += NTHR) { const int j = e >> 7, d = e & 127; Vt[d * LDP + j] = V[(size_t)j * 512 + d]; }
    __syncthreads();
    f32x4 acc[8];
#pragma unroll
    for (int i = 0; i < 8; ++i) acc[i] = (f32x4){0.f, 0.f, 0.f, 0.f};
    mm128(Kt, Vt, F.wave, F.lane, acc);
    float* KVC = (float*)(ws + WS_KVC) + (size_t)unit * 16384; const int r = F.lane & 15, q = F.lane >> 4;
#pragma unroll
    for (int nt = 0; nt < 8; ++nt)
#pragma unroll
        for (int g = 0; g < 4; ++g) KVC[(16 * F.wave + 4 * q + g) * 128 + 16 * nt + r] = acc[nt][g];
    __syncthreads();
}
__device__ __forceinline__ void ret_scan(const Frame& F, const Args& a) {
    unsigned char* ws = a.ws; const float* KVC = (const float*)(ws + WS_KVC); float* SC = (float*)(ws + WS_SC);
    for (int e = F.vcu * NTHR + F.tid; e < NB * HR * 16384; e += F.G * NTHR) {
        const int bh = e >> 14, el = e & 16383, h = bh & 3; const float cd = exp2f(128.0f * gamma_log2(h));
        float s = 0.f;
        for (int c = 0; c < 32; ++c) { SC[((size_t)bh * 32 + c) * 16384 + el] = s; s = cd * s + KVC[((size_t)bh * 32 + c) * 16384 + el]; }
        a.out[O_RSP + (size_t)bh * 16384 + el] = s;
    }
}
__device__ __forceinline__ void ret_out_unit(const Frame& F, const Args& a, int unit) {
    unsigned char* ws = a.ws; const int c = unit & 31, h = (unit >> 5) & 3, b = unit >> 7;
    LAS h16* Qs = (LAS h16*)(F.lds); LAS h16* Ks = (LAS h16*)(F.lds + RT_BYTES); LAS h16* Vt = (LAS h16*)(F.lds + 2 * RT_BYTES); LAS h16* St = (LAS h16*)(F.lds + 3 * RT_BYTES);
    const size_t row0 = (size_t)b * SEQ + c * 128; const float lg2 = gamma_log2(h);
    const f32x2* rot = (const f32x2*)(ws + WS_ROT) + (size_t)(c * 128) * 64;
    load_rot<false>(F, (const h16*)(ws + WS_QR) + row0 * 512 + h * 128, rot, Qs, 1.0f, lg2, 0);
    load_rot<false>(F, (const h16*)(ws + WS_KR) + row0 * 512 + h * 128, rot, Ks, 0.08838834764831845f, lg2, 0);
    const h16* V = (const h16*)(ws + WS_VR) + row0 * 512 + h * 128;
    for (int e = F.tid; e < 128 * 128; e += NTHR) { const int j = e >> 7, d = e & 127; Vt[d * LDP + j] = V[(size_t)j * 512 + d]; }
    const float* S = (const float*)(ws + WS_SC) + (size_t)unit * 16384;
    for (int e = F.tid; e < 128 * 128; e += NTHR) { const int dk = e >> 7, dv = e & 127; St[dv * LDP + dk] = f2h(S[e]); }
    __syncthreads();
    const int r = F.lane & 15, q = F.lane >> 4;
    f32x4 acc[8];
#pragma unroll
    for (int i = 0; i < 8; ++i) acc[i] = (f32x4){0.f, 0.f, 0.f, 0.f};
    mm128(Qs, Ks, F.wave, F.lane, acc);
    __syncthreads();
#pragma unroll
    for (int nt = 0; nt < 8; ++nt)
#pragma unroll
        for (int g = 0; g < 4; ++g) { const int i = 16 * F.wave + 4 * q + g, j = 16 * nt + r; const float v = (i >= j) ? acc[nt][g] * exp2f((float)(i - j) * lg2) : 0.f; Ks[i * LDP + j] = f2h(v); }
    __syncthreads();
    f32x4 o1[8], o2[8];
#pragma unroll
    for (int i = 0; i < 8; ++i) { o1[i] = (f32x4){0.f, 0.f, 0.f, 0.f}; o2[i] = (f32x4){0.f, 0.f, 0.f, 0.f}; }
    mm128(Ks, Vt, F.wave, F.lane, o1);
    mm128(Qs, St, F.wave, F.lane, o2);
    const float* gng = a.in[14] + h * 128; const h16* GR = (const h16*)(ws + WS_GR); h16* MIX = (h16*)(ws + WS_MIX);
#pragma unroll
    for (int g = 0; g < 4; ++g) { const int i = 16 * F.wave + 4 * q + g; const float cross = exp2f((float)(i + 1) * lg2);
        float v[8]; float s = 0.f;
#pragma unroll
        for (int nt = 0; nt < 8; ++nt) { v[nt] = o1[nt][g] + cross * o2[nt][g]; s += v[nt]; }
        s += __shfl_xor(s, 1); s += __shfl_xor(s, 2); s += __shfl_xor(s, 4); s += __shfl_xor(s, 8);
        const float mu = s * (1.f / 128.f); float s2 = 0.f;
#pragma unroll
        for (int nt = 0; nt < 8; ++nt) { v[nt] -= mu; s2 += v[nt] * v[nt]; }
        s2 += __shfl_xor(s2, 1); s2 += __shfl_xor(s2, 2); s2 += __shfl_xor(s2, 4); s2 += __shfl_xor(s2, 8);
        const float rstd = 1.f / sqrtf(s2 * (1.f / 128.f) + GN_EPS);
        const size_t row = row0 + i;
#pragma unroll
        for (int nt = 0; nt < 8; ++nt) { const int dv = 16 * nt + r; const float gt = h2f(GR[row * 512 + h * 128 + dv]);
            MIX[row * DM + 512 + h * 128 + dv] = f2h(v[nt] * rstd * gng[dv] * silu_f(gt)); } }
    __syncthreads();
}
__device__ __forceinline__ void ret_sample_unit(const Frame& F, const Args& a, int unit) {
    unsigned char* ws = a.ws; const int h = unit & 3, b = unit >> 2; const int row = MP + b;
    LAS float* qs = (LAS float*)(F.lds); LAS float* ks = qs + 128; LAS float* part = ks + 128; LAS float* red = part + 512;
    const float lg2 = gamma_log2(h); const float gam = exp2f(lg2);
    const f32x2* rot = (const f32x2*)(ws + WS_ROT) + (size_t)4096 * 64;
    if (F.tid < 128) { const int i = F.tid & 63; const bool second = F.tid >= 64;
        const h16* src = (const h16*)(ws + (F.tid < 128 ? WS_QR : WS_KR)) + (size_t)row * 512 + h * 128;
        const float x1 = h2f(src[i]), x2 = h2f(src[64 + i]); const f32x2 cs = rot[i];
        qs[F.tid] = second ? (x1 * cs[1] + x2 * cs[0]) : (x1 * cs[0] - x2 * cs[1]);
    } else if (F.tid < 256) { const int tt = F.tid - 128; const int i = tt & 63; const bool second = tt >= 64;
        const h16* src = (const h16*)(ws + WS_KR) + (size_t)row * 512 + h * 128;
        const float x1 = h2f(src[i]), x2 = h2f(src[64 + i]); const f32x2 cs = rot[i];
        ks[tt] = (second ? (x1 * cs[1] + x2 * cs[0]) : (x1 * cs[0] - x2 * cs[1])) * 0.08838834764831845f;
    }
    __syncthreads();
    const int dv = F.tid & 127, qd = F.tid >> 7;
    const float v = h2f(((const h16*)(ws + WS_VR))[(size_t)row * 512 + h * 128 + dv]);
    const float* S0 = a.in[5] + ((size_t)b * HR + h) * 16384; float* SN = a.out + O_RSS + ((size_t)b * HR + h) * 16384;
    float po = 0.f, qk = 0.f;
    for (int dk = 32 * qd; dk < 32 * qd + 32; ++dk) { const float s0 = S0[dk * 128 + dv]; po += qs[dk] * s0; SN[dk * 128 + dv] = gam * s0 + ks[dk] * v; qk += qs[dk] * ks[dk]; }
    part[qd * 128 + dv] = po; if (dv == 0) red[qd] = qk;
    __syncthreads();
    if (F.tid < 128) {
        const float qkt = red[0] + red[1] + red[2] + red[3];
        float o = qkt * v + gam * (part[dv] + part[128 + dv] + part[256 + dv] + part[384 + dv]);
        float s = wave_sum(o); if (F.lane == 0) red[8 + F.wave] = s;
        asm volatile("s_waitcnt lgkmcnt(0)" ::: "memory");
        part[dv] = o;
    }
    __syncthreads();
    if (F.tid < 128) {
        const float mu = (red[8] + red[9]) * (1.f / 128.f); const float o = part[dv] - mu;
        float s2 = wave_sum(o * o); if (F.lane == 0) red[12 + F.wave] = s2;
    }
    __syncthreads();
    if (F.tid < 128) {
        const float mu = (red[8] + red[9]) * (1.f / 128.f); const float o = part[dv] - mu;
        const float rstd = 1.f / sqrtf((red[12] + red[13]) * (1.f / 128.f) + GN_EPS);
        const float gt = h2f(((const h16*)(ws + WS_GR))[(size_t)row * 512 + h * 128 + dv]);
        ((h16*)(ws + WS_MIX))[(size_t)row * DM + 512 + h * 128 + dv] = f2h(o * rstd * a.in[14][h * 128 + dv] * silu_f(gt));
    }
    __syncthreads();
}

constexpr int N_PHASES = 13;
__global__ void __launch_bounds__(NTHR, 2) skel_fwd(Args args) {
    extern __shared__ __attribute__((aligned(16))) unsigned char lds[];
    Frame F;
    F.lds = (LAS unsigned char*)lds;
    F.tid = threadIdx.x; F.lane = F.tid & 63; F.wave = __builtin_amdgcn_readfirstlane(F.tid >> 6);
    F.G = gridDim.x; { const int bx = blockIdx.x; F.vcu = (F.G % 8 == 0) ? (bx % 8) * (F.G / 8) + bx / 8 : bx; }
    unsigned char* ws = args.ws;
    const int lo = args.ph_lo, hi = args.ph_hi;
    for (int u = F.tid; u < (LDS_BYTES - LDSCTL_OFF) / 4; u += NTHR) ((LAS unsigned*)(F.lds + LDSCTL_OFF))[u] = 0u;
    __syncthreads();
    XcdBarrier bar = xcd_barrier_post((unsigned*)(ws + WS_CTL) + CW_BAR, (volatile LAS unsigned*)(F.lds + MISC_OFF) + 8);
#define IN(k) (lo <= (k) && (k) < hi)
#define GRID_BAR(k) do { if (IN(k) && IN((k) + 1)) xcd_barrier(bar); } while (0)
    if (IN(0)) { p0_prologue(F, args); }
    GRID_BAR(0);
    if (IN(1)) {
        pg8::Gemm g{(const h16*)(ws + WS_X16), (const h16*)(ws + WS_WGU1), MR, 2 * DFF, DM}; pg8::StaticOrder S; S.init(MR, 2 * DFF, F.G, (int)blockIdx.x);
        pg8::EpiSwiglu E{(h16*)(ws + WS_H1), DFF};
        pg8::gemm_phase<pg8::EpiSwiglu, pg8::StaticOrder, true>(F.lds, g, S, E);
    }
    GRID_BAR(1);
    if (IN(2)) {
        pg8::Gemm g{(const h16*)(ws + WS_H1), (const h16*)(ws + WS_WD1), MR, DM, DFF}; pg8::StaticOrder S; S.init(MR, DM, F.G, (int)blockIdx.x);
        pg8::EpiResid E{(const float*)(ws + WS_HF), (float*)(ws + WS_V), DM, ALPHA, 0.5f};
        pg8::gemm_phase<pg8::EpiResid, pg8::StaticOrder, true>(F.lds, g, S, E);
    }
    GRID_BAR(2);
    if (IN(3)) { ln_rows(F, (const float*)(ws + WS_V), args.in[11], args.in[12], (float*)(ws + WS_HF), (h16*)(ws + WS_H16), MV); }
    GRID_BAR(3);
    if (IN(4)) {
        pg8::Gemm g{(const h16*)(ws + WS_H16), (const h16*)(ws + WS_WIN), MR, NINP, DM}; pg8::StaticOrder S; S.init(MR, NINP, F.G, (int)blockIdx.x);
        pg8::EpiWin E; E.p16base = (h16*)(ws + WS_QA); E.p16stride = SZ_P16 / 2;
        E.ki16 = (h16*)(ws + WS_KI); E.wi = (float*)(ws + WS_WI); E.dout = args.out;
        pg8::gemm_phase<pg8::EpiWin, pg8::StaticOrder, true>(F.lds, g, S, E);
    }
    GRID_BAR(4);
    if (IN(5)) {
        for (int u = F.vcu; u < NB * HR * 32; u += F.G) ret_kv_unit(F, args, u);
        for (int qi = F.vcu; qi < MP + NS; qi += F.G) { if (qi < NS) sparse_query<true>(F, args, qi); else sparse_query<false>(F, args, qi - NS); }
    }
    GRID_BAR(5);
    if (IN(6)) { ret_scan(F, args); for (int u = F.vcu; u < NS * HR; u += F.G) ret_sample_unit(F, args, u); }
    GRID_BAR(6);
    if (IN(7)) { for (int u = F.vcu; u < NB * HR * 32; u += F.G) ret_out_unit(F, args, u); }
    GRID_BAR(7);
    if (IN(8)) {
        pg8::Gemm g{(const h16*)(ws + WS_MIX), (const h16*)(ws + WS_WOUT), MR, DM, DM}; pg8::StaticOrder S; S.init(MR, DM, F.G, (int)blockIdx.x);
        pg8::EpiResid E{(const float*)(ws + WS_HF), (float*)(ws + WS_V), DM, ALPHA, 1.0f};
        pg8::gemm_phase<pg8::EpiResid, pg8::StaticOrder, true>(F.lds, g, S, E);
    }
    GRID_BAR(8);
    if (IN(9)) { ln_rows(F, (const float*)(ws + WS_V), args.in[16], args.in[17], (float*)(ws + WS_HF), (h16*)(ws + WS_H16), MV); }
    GRID_BAR(9);
    if (IN(10)) {
        pg8::Gemm g{(const h16*)(ws + WS_H16), (const h16*)(ws + WS_WGU2), MR, 2 * DFF, DM}; pg8::StaticOrder S; S.init(MR, 2 * DFF, F.G, (int)blockIdx.x);
        pg8::EpiSwiglu E{(h16*)(ws + WS_H1), DFF};
        pg8::gemm_phase<pg8::EpiSwiglu, pg8::StaticOrder, true>(F.lds, g, S, E);
    }
    GRID_BAR(10);
    if (IN(11)) {
        pg8::Gemm g{(const h16*)(ws + WS_H1), (const h16*)(ws + WS_WD2), MR, DM, DFF}; pg8::StaticOrder S; S.init(MR, DM, F.G, (int)blockIdx.x);
        pg8::EpiResid E{(const float*)(ws + WS_HF), (float*)(ws + WS_V), DM, ALPHA, 0.5f};
        pg8::gemm_phase<pg8::EpiResid, pg8::StaticOrder, true>(F.lds, g, S, E);
    }
    GRID_BAR(11);
    if (IN(12)) { ln_rows(F, (const float*)(ws + WS_V), args.in[21], args.in[22], args.out + O_Y, nullptr, MV); }
#undef IN
#undef GRID_BAR
}

extern "C" void kernel_launch(void* const* d_in, const int* in_sizes, int n_in, void* d_out, int out_size, void* d_ws, size_t ws_size, hipStream_t stream) {
    static int grid = 0;
    if (grid == 0) {
        if (n_in != 23 || out_size != (int)O_END || ws_size < WS_END) { fprintf(stderr, "kernel_launch: unexpected sizes (n_in %d out %d ws %zu need %zu)\n", n_in, out_size, ws_size, (size_t)WS_END); grid = -1; return; }
        int dev = 0, cus = 0;
        if (hipGetDevice(&dev) != hipSuccess || hipDeviceGetAttribute(&cus, hipDeviceAttributeMultiprocessorCount, dev) != hipSuccess) { grid = -1; return; }
        if (hipFuncSetAttribute((const void*)skel_fwd, hipFuncAttributeMaxDynamicSharedMemorySize, LDS_BYTES) != hipSuccess) { fprintf(stderr, "kernel_launch: hipFuncSetAttribute failed\n"); grid = -1; return; }
        (void)hipGetLastError();
        grid = cus;
    }
    if (grid < 0) return;
    Args a{};
    for (int i = 0; i < 23; ++i) a.in[i] = (const float*)d_in[i];
    a.page_table = (const int*)d_in[6];
    a.out = (float*)d_out; a.ws = (unsigned char*)d_ws;
    if (hipMemsetAsync((char*)d_ws + WS_CTL, 0, CTL_ZERO_BYTES, stream) != hipSuccess) { fprintf(stderr, "kernel_launch: memset failed\n"); return; }
    a.ph_lo = 0; a.ph_hi = N_PHASES;
    hipLaunchKernelGGL(skel_fwd, dim3(grid), dim3(NTHR), LDS_BYTES, stream, a);
}
```

```cpp
#include <hip/hip_runtime.h>
#include <cstdio>
#include <cstdint>

#define LAS __attribute__((address_space(3)))
#define GAS __attribute__((address_space(1)))
typedef unsigned short h16;
typedef short s16x8 __attribute__((ext_vector_type(8)));
typedef _Float16 f16x8 __attribute__((ext_vector_type(8)));
typedef _Float16 f16x2 __attribute__((ext_vector_type(2)));
typedef float f32x2 __attribute__((ext_vector_type(2)));
typedef float f32x4 __attribute__((ext_vector_type(4)));
typedef unsigned u32x4 __attribute__((ext_vector_type(4)));
typedef unsigned u32x2 __attribute__((ext_vector_type(2)));
typedef GAS unsigned gu32;

constexpr int DM = 1024, NB = 4, SEQ = 4096, MP = NB * SEQ, NS = 32, MR = MP + 256, MV = MP + NS, DFF = 2816;
constexpr int WA = 512, WRT = 512, HA = 8, DHA = 64, HR = 4, DKR = 128;
constexpr int NIN = 4168, NINP = 4352;
constexpr int PAST = 8192, PAGE = 128, NPAGES = 64, LS = PAST + 1, TOPK = 256;
constexpr float ALPHA = 1.189207115002721f;
constexpr float LN_EPS = 1e-5f, GN_EPS = 1e-5f;
constexpr int C_QA = 0, C_KA = 512, C_VA = 1024, C_QI = 1536, C_KI = 2048, C_WI = 2112, C_QR = 2120, C_KR = 2632, C_VR = 3144, C_GR = 3656;
constexpr size_t O_Y = 0, O_YS = (size_t)MP * DM, O_KP = O_YS + (size_t)NS * DM, O_VP = O_KP + (size_t)MP * WA, O_KIP = O_VP + (size_t)MP * WA,
                 O_RSP = O_KIP + (size_t)MP * 64, O_KS = O_RSP + (size_t)NB * HR * 128 * 128, O_VS = O_KS + (size_t)NS * WA, O_KIS = O_VS + (size_t)NS * WA,
                 O_RSS = O_KIS + (size_t)NS * 64, O_END = O_RSS + (size_t)NS * HR * 128 * 128;
static_assert(O_END == 37029888, "d_out size");

constexpr size_t MiB = 1u << 20;
constexpr size_t al(size_t x) { return (x + MiB - 1) / MiB * MiB; }
constexpr size_t WS_CTL = 0, CTL_ZERO_BYTES = 1 * MiB;
constexpr size_t WS_WGU1 = 2 * MiB;
constexpr size_t WS_WD1 = WS_WGU1 + al((size_t)2 * DFF * DM * 2);
constexpr size_t WS_WIN = WS_WD1 + al((size_t)DM * DFF * 2);
constexpr size_t WS_WOUT = WS_WIN + al((size_t)NINP * DM * 2);
constexpr size_t WS_WGU2 = WS_WOUT + al((size_t)DM * DM * 2);
constexpr size_t WS_WD2 = WS_WGU2 + al((size_t)2 * DFF * DM * 2);
constexpr size_t WS_ROT = WS_WD2 + al((size_t)DM * DFF * 2);
constexpr size_t WS_X16 = WS_ROT + al((size_t)4097 * 64 * 8);
constexpr size_t WS_H1 = WS_X16 + al((size_t)MR * DM * 2);
constexpr size_t WS_V = WS_H1 + al((size_t)MR * DFF * 2);
constexpr size_t WS_HF = WS_V + al((size_t)MR * DM * 4);
constexpr size_t WS_H16 = WS_HF + al((size_t)MR * DM * 4);
constexpr size_t SZ_P16 = al((size_t)MR * 512 * 2);
constexpr size_t WS_QA = WS_H16 + al((size_t)MR * DM * 2);
constexpr size_t WS_KA = WS_QA + SZ_P16, WS_VA = WS_KA + SZ_P16, WS_QI = WS_VA + SZ_P16, WS_QR = WS_QI + SZ_P16, WS_KR = WS_QR + SZ_P16, WS_VR = WS_KR + SZ_P16, WS_GR = WS_VR + SZ_P16;
constexpr size_t WS_KI = WS_GR + SZ_P16;
constexpr size_t WS_WI = WS_KI + al((size_t)MR * 64 * 2);
constexpr size_t WS_MIX = WS_WI + al((size_t)MR * 8 * 4);
constexpr size_t WS_KVC = WS_MIX + al((size_t)MR * DM * 2);
constexpr size_t WS_SC = WS_KVC + al((size_t)NB * HR * 32 * 16384 * 4);
constexpr size_t WS_MASK = WS_SC + al((size_t)NB * HR * 32 * 16384 * 4);
constexpr size_t WS_SCORE = WS_MASK + al((size_t)MP * 64 * 8);
constexpr size_t WS_SSC = WS_SCORE + al((size_t)MP * SEQ * 4);
constexpr int SSC_PITCH = 8256;
constexpr size_t WS_END = WS_SSC + al((size_t)NS * SSC_PITCH * 4);

constexpr int CW_TMO = 0, CW_CODE = 1, CW_BAR = 4096;

constexpr int RING_BYTES = 131072;
constexpr int LDS_BYTES = 147456;
constexpr int LDSCTL_OFF = LDS_BYTES - 512, MISC_OFF = LDSCTL_OFF + 320;
constexpr int WORK_BYTES = LDSCTL_OFF;
constexpr int NWAVES = 8, NTHR = 512;

__device__ __forceinline__ unsigned pkh(float a, float b) { f32x2 v = {a, b}; f16x2 h = __builtin_convertvector(v, f16x2); return __builtin_bit_cast(unsigned, h); }
typedef __bf16 bf16x2 __attribute__((ext_vector_type(2)));
__device__ __forceinline__ unsigned pkb(float a, float b) { f32x2 v = {a, b}; bf16x2 h = __builtin_convertvector(v, bf16x2); return __builtin_bit_cast(unsigned, h); }
constexpr float QA_SCALE = 0.125f * 1.4426950408889634f;
__device__ __forceinline__ h16 f2h(float a) { _Float16 h = (_Float16)a; return __builtin_bit_cast(h16, h); }
__device__ __forceinline__ float h2f(h16 a) { return (float)__builtin_bit_cast(_Float16, a); }
__device__ __forceinline__ float hlo(unsigned w) { return h2f((h16)(w & 0xffffu)); }
__device__ __forceinline__ float hhi(unsigned w) { return h2f((h16)(w >> 16)); }
__device__ __forceinline__ int opaque(int x) { asm volatile("" : "+v"(x)); return x; }
#define LDS_WAIT() asm volatile("s_waitcnt lgkmcnt(0)" ::: "memory")
#define VM_WAIT() asm volatile("s_waitcnt vmcnt(0)" ::: "memory")
__device__ __forceinline__ float wave_sum(float v) {
#pragma unroll
    for (int o = 1; o < 64; o <<= 1) v += __shfl_xor(v, o);
    return v;
}
__device__ __forceinline__ float wave_max(float v) {
#pragma unroll
    for (int o = 1; o < 64; o <<= 1) v = fmaxf(v, __shfl_xor(v, o));
    return v;
}
__device__ __forceinline__ float silu_f(float g) { return g * __builtin_amdgcn_rcpf(1.0f + __builtin_amdgcn_exp2f(-1.4426950408889634f * g)); }

namespace pg8 {
constexpr int BM = 256, BK = 64, HALF = 128, HTB = HALF * BK * 2, STAGE_BYTES = 8 * HTB, NXCD = 8, WGM = 8;
__host__ __device__ __forceinline__ int lds_byte(int r, int c) { const int st = (r >> 4) * 2 + (c >> 5), rr = r & 15, cc = c & 31, ob = rr * 64 + cc * 2; return st * 1024 + (ob ^ (((ob >> 9) & 1) << 5)); }
__host__ __device__ __forceinline__ void stage_rc(int b, int& R, int& C) { const int st = b / 1024, sb = b % 1024, swz = sb ^ (((sb >> 9) & 1) << 5); R = (st >> 1) * 16 + swz / 64; C = (st & 1) * 32 + (swz % 64) / 2; }
__host__ __device__ __forceinline__ int perm32(int rho) { const int n = rho >> 4, i = rho & 15; return 8 * (i >> 2) + 4 * n + (i & 3); }
struct Unit { int pm, pn; };
struct Gemm { const h16* A; const h16* Bt; int M, N, K; };
struct StaticOrder {
    int nM, nN, nwg, G, c;
    __host__ __device__ void init(int M, int N, int G_, int c_) { nM = M / BM; nN = N / BM; nwg = nM * nN; G = G_; c = c_; }
    __host__ __device__ bool next(int i, Unit& u) const {
        const long L = (long)i * G + c; if (L >= nwg) return false;
        int wgid = (int)L; { const int q = nwg / NXCD, r = nwg % NXCD, xcd = wgid % NXCD, off = wgid / NXCD; wgid = (xcd < r ? xcd * (q + 1) : r * (q + 1) + (xcd - r) * q) + off; }
        const int nig = WGM * nN, gid = wgid / nig, fm = gid * WGM, gsz = (nM - fm) < WGM ? (nM - fm) : WGM;
        u.pm = fm + ((wgid % nig) % gsz); u.pn = (wgid % nig) / gsz; return true;
    }
    __device__ __forceinline__ void a_ready(const Unit&) const {}
    __device__ __forceinline__ void done(const Unit&) const {}
};

struct EpiSwiglu {
    static constexpr bool PERM = true, AFTER_DRAIN = false;
    h16* O; int ldc;
    __device__ __forceinline__ void operator()(const f32x4 (&acc)[2][2][4][2], const Unit& u, int wr, int wc, int fr, int fq) const {
        const int row0 = u.pm * BM + wr * 64 + fr; const int col0 = u.pn * HALF + wc * 32 + 8 * fq;
#pragma unroll
        for (int ai = 0; ai < 2; ++ai)
#pragma unroll
            for (int m = 0; m < 4; ++m) {
                h16* rowp = O + (size_t)(row0 + ai * HALF + m * 16) * ldc + col0;
                const f32x4 g0 = acc[ai][0][m][0], g1 = acc[ai][0][m][1], u0 = acc[ai][1][m][0], u1 = acc[ai][1][m][1];
                u32x4 w;
                w.x = pkh(silu_f(g0[0]) * u0[0], silu_f(g0[1]) * u0[1]); w.y = pkh(silu_f(g0[2]) * u0[2], silu_f(g0[3]) * u0[3]);
                w.z = pkh(silu_f(g1[0]) * u1[0], silu_f(g1[1]) * u1[1]); w.w = pkh(silu_f(g1[2]) * u1[2], silu_f(g1[3]) * u1[3]);
                *(u32x4*)rowp = w;
            }
    }
};
struct EpiResid {
    static constexpr bool PERM = false, AFTER_DRAIN = false;
    const float* base; float* out; int ldc; float alpha, s;
    __device__ __forceinline__ void operator()(const f32x4 (&acc)[2][2][4][2], const Unit& u, int wr, int wc, int fr, int fq) const {
        const int col0 = u.pn * BM + wc * 32 + 4 * fq;
#pragma unroll
        for (int ai = 0; ai < 2; ++ai)
#pragma unroll
            for (int m = 0; m < 4; ++m) { const size_t off = (size_t)(u.pm * BM + ai * HALF + wr * 64 + m * 16 + fr) * ldc + col0;
#pragma unroll
                for (int bj = 0; bj < 2; ++bj)
#pragma unroll
                    for (int n = 0; n < 2; ++n) { const f32x4 bs = *(const f32x4*)(base + off + bj * HALF + n * 16); *(f32x4*)(out + off + bj * HALF + n * 16) = bs * alpha + acc[ai][bj][m][n] * s; } }
    }
};
struct EpiWin {
    static constexpr bool PERM = true, AFTER_DRAIN = false;
    h16* p16base; size_t p16stride;
    h16* ki16; float* wi;
    float* dout;
    __device__ __forceinline__ void operator()(const f32x4 (&acc)[2][2][4][2], const Unit& u, int wr, int wc, int fr, int fq) const {
        const int row0 = u.pm * BM + wr * 64 + fr;
        if (u.pn < 16) {
            const int seg = u.pn >> 1; h16* base = p16base + (size_t)seg * p16stride; const int colt = (u.pn & 1) * 256 + wc * 32 + 8 * fq;
            float* o32 = nullptr; float* o32s = nullptr;
            if (seg == 1) { o32 = dout + O_KP; o32s = dout + O_KS; } else if (seg == 2) { o32 = dout + O_VP; o32s = dout + O_VS; }
#pragma unroll
            for (int ai = 0; ai < 2; ++ai)
#pragma unroll
                for (int m = 0; m < 4; ++m) { const int row = row0 + ai * HALF + m * 16;
#pragma unroll
                    for (int bj = 0; bj < 2; ++bj) { const f32x4 v0 = acc[ai][bj][m][0], v1 = acc[ai][bj][m][1]; const int col = colt + bj * HALF;
                        u32x4 w;
                        if (seg == 2) { w.x = pkb(v0[0], v0[1]); w.y = pkb(v0[2], v0[3]); w.z = pkb(v1[0], v1[1]); w.w = pkb(v1[2], v1[3]); }
                        else { const float sc = (seg == 0) ? QA_SCALE : 1.0f; w.x = pkh(v0[0] * sc, v0[1] * sc); w.y = pkh(v0[2] * sc, v0[3] * sc); w.z = pkh(v1[0] * sc, v1[1] * sc); w.w = pkh(v1[2] * sc, v1[3] * sc); }
                        *(u32x4*)(base + (size_t)row * 512 + col) = w;
                        if (o32) { float* d = nullptr; if (row < MP) d = o32 + (size_t)row * 512 + col; else if (row < MV) d = o32s + (size_t)(row - MP) * 512 + col;
                            if (d) { *(f32x4*)d = v0; *(f32x4*)(d + 4) = v1; } } } }
        } else {
#pragma unroll
            for (int ai = 0; ai < 2; ++ai)
#pragma unroll
                for (int m = 0; m < 4; ++m) { const int row = row0 + ai * HALF + m * 16; const f32x4 v0 = acc[ai][0][m][0], v1 = acc[ai][0][m][1];
                    if (wc < 2) { const int col = wc * 32 + 8 * fq;
                        u32x4 w; w.x = pkh(v0[0], v0[1]); w.y = pkh(v0[2], v0[3]); w.z = pkh(v1[0], v1[1]); w.w = pkh(v1[2], v1[3]);
                        *(u32x4*)(ki16 + (size_t)row * 64 + col) = w;
                        float* d = nullptr; if (row < MP) d = dout + O_KIP + (size_t)row * 64 + col; else if (row < MV) d = dout + O_KIS + (size_t)(row - MP) * 64 + col;
                        if (d) { *(f32x4*)d = v0; *(f32x4*)(d + 4) = v1; }
                    } else if (wc == 2 && fq == 0) { *(f32x4*)(wi + (size_t)row * 8) = v0; *(f32x4*)(wi + (size_t)row * 8 + 4) = v1; } }
        }
    }
};

template <class Epi, class Sched, bool ALIGN_EPI = false>
__device__ __forceinline__ void gemm_phase(LAS unsigned char* lds, const Gemm g, const Sched& S, const Epi& E) {
    const int tid = threadIdx.x, wid = __builtin_amdgcn_readfirstlane(tid >> 6), lane = tid & 63, wr = wid >> 2, wc = wid & 3, fr = lane & 15, fq = lane >> 4;
    const int K = g.K, nt = K / BK;
    unsigned voffA[2], voffB[2];
#pragma unroll
    for (int i = 0; i < 2; ++i) { int R, C; stage_rc(tid * 16 + i * 8192, R, C); const int Rb = Epi::PERM ? ((R & ~31) + perm32(R & 31)) : R;
        voffA[i] = (unsigned)(R * K + C) * 2u; voffB[i] = (unsigned)(Rb * K + C) * 2u; }
    const size_t kstep = (size_t)(BK * 2);
    const size_t hstep = (size_t)HALF * K * 2;
    const size_t tstep = 2 * hstep;
    const unsigned ldsw = (unsigned)wid * 1024u;
    const int aoff = lds_byte(wr * 64 + fr, fq * 8), boff = lds_byte(wc * 32 + fr, fq * 8);
#define PG8_SA(b, h) (((b) * 2 + (h)) * HTB)
#define PG8_SB(b, h) ((4 + (b) * 2 + (h)) * HTB)
#define PG8_STAGE(bufoff, gbase, voff) do { _Pragma("unroll") for (int _i = 0; _i < 2; ++_i) \
        __builtin_amdgcn_global_load_lds((const unsigned*)((const char*)(gbase) + (voff)[_i]), (LAS unsigned*)(lds + (bufoff) + ldsw + _i * 8192), 16, 0, 0); } while (0)
#define PG8_LDA(dst, b, h) do { _Pragma("unroll") for (int m = 0; m < 4; ++m) _Pragma("unroll") for (int k = 0; k < 2; ++k) dst[m][k] = *(const LAS s16x8*)(lds + PG8_SA(b, h) + aoff + m * 2048 + k * 1024); } while (0)
#define PG8_LDB(dst, b, h) do { _Pragma("unroll") for (int n = 0; n < 2; ++n) _Pragma("unroll") for (int k = 0; k < 2; ++k) dst[n][k] = *(const LAS s16x8*)(lds + PG8_SB(b, h) + boff + n * 2048 + k * 1024); } while (0)
#define PG8_MMA(ai, bj, At, Bt) do { __builtin_amdgcn_s_setprio(1); _Pragma("unroll") for (int m = 0; m < 4; ++m) _Pragma("unroll") for (int n = 0; n < 2; ++n) _Pragma("unroll") for (int k = 0; k < 2; ++k) \
        acc[ai][bj][m][n] = __builtin_amdgcn_mfma_f32_16x16x32_f16(__builtin_bit_cast(f16x8, Bt[n][k]), __builtin_bit_cast(f16x8, At[m][k]), acc[ai][bj][m][n], 0, 0, 0); __builtin_amdgcn_s_setprio(0); } while (0)
#define PG8_WAIT_V(n) asm volatile("s_waitcnt vmcnt(" #n ")" ::: "memory")
#define PG8_WAIT_L(n) asm volatile("s_waitcnt lgkmcnt(" #n ")" ::: "memory")
#define PG8_BAR __builtin_amdgcn_s_barrier()
#define PG8_SCHED __builtin_amdgcn_sched_barrier(0)
    Unit cur, nxt; int ui = 0;
    if (!S.next(0, cur)) return;
    f32x4 acc[2][2][4][2];
#pragma unroll
    for (int a = 0; a < 2; ++a)
#pragma unroll
        for (int b = 0; b < 2; ++b)
#pragma unroll
            for (int m = 0; m < 4; ++m)
#pragma unroll
                for (int n = 0; n < 2; ++n) acc[a][b][m][n] = (f32x4){0.f, 0.f, 0.f, 0.f};
    s16x8 At[4][2], B0[2][2], B1[2][2];
    const char* cA = (const char*)g.A + (size_t)cur.pm * tstep; const char* cB = (const char*)g.Bt + (size_t)cur.pn * tstep;
    S.a_ready(cur);
    PG8_STAGE(PG8_SB(0, 0), cB, voffB); PG8_STAGE(PG8_SB(0, 1), cB + hstep, voffB); PG8_STAGE(PG8_SA(0, 0), cA, voffA); PG8_STAGE(PG8_SA(0, 1), cA + hstep, voffA);
    if (wr == 1) PG8_BAR;
    PG8_WAIT_V(2); PG8_BAR;
    PG8_STAGE(PG8_SB(1, 0), cB + kstep, voffB); PG8_STAGE(PG8_SA(1, 0), cA + kstep, voffA); PG8_STAGE(PG8_SB(1, 1), cB + hstep + kstep, voffB);
    PG8_WAIT_V(6); PG8_BAR;
    for (;;) {
        const bool has_next = S.next(ui + 1, nxt);
        const char* nA = has_next ? (const char*)g.A + (size_t)nxt.pm * tstep : cA; const char* nB = has_next ? (const char*)g.Bt + (size_t)nxt.pn * tstep : cB;
        for (int t = 0; t < nt; t += 2) {
            const bool last = (t == nt - 2);
            const char* a1 = cA + (size_t)(t + 1) * kstep;
            const char* a2 = last ? nA : cA + (size_t)(t + 2) * kstep; const char* b2 = last ? nB : cB + (size_t)(t + 2) * kstep;
            const char* a3 = a2 + kstep; const char* b3 = b2 + kstep;
            if (last && has_next) S.a_ready(nxt);
            PG8_LDB(B0, 0, 0); PG8_LDB(B1, 0, 1); PG8_SCHED; PG8_LDA(At, 0, 0); PG8_STAGE(PG8_SA(1, 1), a1 + hstep, voffA);
            PG8_WAIT_V(8); PG8_WAIT_L(0); PG8_BAR; PG8_MMA(0, 0, At, B0); PG8_MMA(0, 1, At, B1); PG8_BAR; PG8_SCHED;
            PG8_LDA(At, 0, 1); PG8_STAGE(PG8_SB(0, 0), b2, voffB); PG8_STAGE(PG8_SB(0, 1), b2 + hstep, voffB); PG8_STAGE(PG8_SA(0, 0), a2, voffA);
            PG8_WAIT_V(8); PG8_WAIT_L(0); PG8_BAR; PG8_MMA(1, 0, At, B0); PG8_MMA(1, 1, At, B1); PG8_BAR; PG8_SCHED;
            PG8_LDB(B0, 1, 0); PG8_LDB(B1, 1, 1); PG8_SCHED; PG8_LDA(At, 1, 0); PG8_STAGE(PG8_SA(0, 1), a2 + hstep, voffA);
            PG8_WAIT_V(8); PG8_WAIT_L(0); PG8_BAR; PG8_MMA(0, 0, At, B0); PG8_MMA(0, 1, At, B1); PG8_BAR; PG8_SCHED;
            PG8_LDA(At, 1, 1); PG8_STAGE(PG8_SB(1, 0), b3, voffB); PG8_STAGE(PG8_SB(1, 1), b3 + hstep, voffB); PG8_STAGE(PG8_SA(1, 0), a3, voffA);
            PG8_WAIT_V(8); PG8_WAIT_L(0); PG8_BAR; PG8_MMA(1, 0, At, B0); PG8_MMA(1, 1, At, B1); PG8_BAR; PG8_SCHED;
        }
        if constexpr (ALIGN_EPI) { if (wr == 0) PG8_BAR; }
        E(acc, cur, wr, wc, fr, fq); S.done(cur);
        if (!has_next) break;
#pragma unroll
        for (int a = 0; a < 2; ++a)
#pragma unroll
            for (int b = 0; b < 2; ++b)
#pragma unroll
                for (int m = 0; m < 4; ++m)
#pragma unroll
                    for (int n = 0; n < 2; ++n) acc[a][b][m][n] = (f32x4){0.f, 0.f, 0.f, 0.f};
        cur = nxt; cA = nA; cB = nB; ++ui;
        if constexpr (ALIGN_EPI) { if (wr == 1) PG8_BAR; }
    }
    PG8_WAIT_V(0);
    if constexpr (!ALIGN_EPI) { if (wr == 0) PG8_BAR; }
    PG8_BAR;
#undef PG8_SA
#undef PG8_SB
#undef PG8_STAGE
#undef PG8_LDA
#undef PG8_LDB
#undef PG8_MMA
#undef PG8_WAIT_V
#undef PG8_WAIT_L
#undef PG8_BAR
#undef PG8_SCHED
}
}

#define XB_TMO      128
#define XB_XCNT(j)  (256  + 64 * (j))
#define XB_XSUB(j)  (1280 + 64 * (j))
#define XB_XGEN(j)  (2304 + 64 * (j))
#define XB_TOP      3328
#define XB_TOPGEN   3392
#define XCD_BAR_WORDS 3456
#define XB_SPIN_CAP (1u << 18)

__device__ __forceinline__ unsigned xb_ld(unsigned* p)              { return __hip_atomic_load(p, __ATOMIC_RELAXED, __HIP_MEMORY_SCOPE_AGENT); }
__device__ __forceinline__ unsigned xb_add(unsigned* p, unsigned v) { return __hip_atomic_fetch_add(p, v, __ATOMIC_RELAXED, __HIP_MEMORY_SCOPE_AGENT); }
__device__ __forceinline__ unsigned xb_xcc_id() { return (unsigned)__builtin_amdgcn_s_getreg((3 << 11) | 20) & 0xFu; }
#define XB_SPIN(cond, bar) do { unsigned _sp = 0; while (cond) { __builtin_amdgcn_s_sleep(1); \
    if ((++_sp & 255u) == 0u) { if (xb_ld(&(bar)[XB_TMO])) break; if (_sp > XB_SPIN_CAP) { atomicAdd(&(bar)[XB_TMO], 1u); break; } } } } while (0)

struct XcdBarrier {
    unsigned* bar; unsigned x;
    volatile LAS unsigned* st;
};

__device__ __forceinline__ XcdBarrier xcd_barrier_post(unsigned* bar, volatile LAS unsigned* st) {
    XcdBarrier b; b.bar = bar; b.x = xb_xcc_id(); b.st = st;
    if (threadIdx.x == 0) (void)xb_add(&bar[XB_XCNT(b.x)], 1u);
    return b;
}
__device__ __forceinline__ void xcd_barrier_complete(unsigned* bar, unsigned x, unsigned& nloc, unsigned& nx) {
    const unsigned G = gridDim.x * gridDim.y * gridDim.z;
    unsigned sum, cnt, mine, sp = 0u;
    for (;;) {
        sum = 0u; cnt = 0u; mine = 0u;
#pragma unroll
        for (unsigned j = 0; j < 16; ++j) { const unsigned c = xb_ld(&bar[XB_XCNT(j)]); sum += c; cnt += (c > 0u) ? 1u : 0u; mine = (j == x) ? c : mine; }
        if (sum == G) break;
        __builtin_amdgcn_s_sleep(1);
        if ((++sp & 255u) == 0u) { if (xb_ld(&bar[XB_TMO])) break; if (sp > XB_SPIN_CAP) { atomicAdd(&bar[XB_TMO], 1u); break; } }
    }
    nloc = mine > 0u ? mine : 1u; nx = cnt > 0u ? cnt : 1u;
}

__device__ __forceinline__ void xcd_barrier(const XcdBarrier& b) {
    asm volatile("s_waitcnt vmcnt(0)" ::: "memory");
    __syncthreads();
    if (threadIdx.x == 0) {
        unsigned* bar = b.bar;
        __builtin_amdgcn_s_waitcnt(0);
        unsigned nloc = b.st[0], nx = b.st[1];
        if (nloc == 0u) { xcd_barrier_complete(bar, b.x, nloc, nx); b.st[0] = nloc; b.st[1] = nx; }
        const unsigned old = xb_add(&bar[XB_XSUB(b.x)], 1u);
        const unsigned gen = old / nloc;
        if (old + 1u == (gen + 1u) * nloc) {
            __builtin_amdgcn_fence(__ATOMIC_RELEASE, "agent");
            asm volatile("s_waitcnt vmcnt(0)" ::: "memory");
            const unsigned og = xb_add(&bar[XB_TOP], 1u);
            const unsigned tg = og / nx;
            if (og + 1u == (tg + 1u) * nx) xb_add(&bar[XB_TOPGEN], 1u);
            else XB_SPIN(xb_ld(&bar[XB_TOPGEN]) == tg, bar);
            __builtin_amdgcn_fence(__ATOMIC_ACQUIRE, "agent");
            xb_add(&bar[XB_XGEN(b.x)], 1u);
            asm volatile("s_waitcnt vmcnt(0)" ::: "memory");
        } else {
            XB_SPIN(xb_ld(&bar[XB_XGEN(b.x)]) == gen, bar);
            __builtin_amdgcn_fence(__ATOMIC_ACQUIRE, "agent");
            asm volatile("s_waitcnt vmcnt(0)" ::: "memory");
        }
    }
    __syncthreads();
}

struct Args { const float* in[23]; const int* page_table; float* out; unsigned char* ws; int ph_lo, ph_hi; };
struct Frame {
    LAS unsigned char* lds;
    int tid, lane, wave, vcu, G;
};

__device__ __forceinline__ void p0_transpose_item(const float* W, int K, int N, int src0, int nvalid, h16* WT, int dst0, int kb, LAS float* scr, int lane) {
    const int k0 = 64 * kb;
#pragma unroll 8
    for (int i = 0; i < 32; ++i) { const int kk = 2 * i + (lane >> 5); const int n = lane & 31; scr[kk * 33 + n] = (n < nvalid) ? W[(size_t)(k0 + kk) * N + src0 + n] : 0.f; }
    LDS_WAIT(); asm volatile("" ::: "memory");
    const int c = lane & 7;
#pragma unroll
    for (int j = 0; j < 4; ++j) { const int n = (lane >> 3) + 8 * j; const LAS float* s = scr + (8 * c) * 33 + n;
        u32x4 o; o.x = pkh(s[0 * 33], s[1 * 33]); o.y = pkh(s[2 * 33], s[3 * 33]); o.z = pkh(s[4 * 33], s[5 * 33]); o.w = pkh(s[6 * 33], s[7 * 33]);
        *(GAS u32x4*)(WT + (size_t)(dst0 + n) * K + k0 + 8 * c) = o; }
    LDS_WAIT(); asm volatile("" ::: "memory");
}
__device__ __forceinline__ void p0_prologue(const Frame& F, const Args& a) {
    unsigned char* ws = a.ws;
    LAS float* scr = (LAS float*)(F.lds + F.wave * 16384);
    const int gw = F.vcu * NWAVES + F.wave, NGW = F.G * NWAVES;
    constexpr int I_G = 16 * 88, I_D = 44 * 32, I_IN = 16 * 136, I_O = 16 * 32;
    constexpr int NITEMS = 4 * I_G + 2 * I_D + I_IN + I_O;
    for (int it = gw; it < NITEMS; it += NGW) {
        int r = it;
        if (r < 4 * I_G) { const int which = r / I_G; r %= I_G; const int kb = r / 88, nb = r % 88, n0 = nb * 32;
            const float* W = a.in[which == 0 ? 8 : which == 1 ? 9 : which == 2 ? 18 : 19]; h16* WT = (h16*)(ws + (which < 2 ? WS_WGU1 : WS_WGU2));
            const int dst = (n0 / 128) * 256 + (n0 % 128) + ((which & 1) ? 128 : 0);
            p0_transpose_item(W, DM, DFF, n0, 32, WT, dst, kb, scr, F.lane); continue; }
        r -= 4 * I_G;
        if (r < 2 * I_D) { const int which = r / I_D; r %= I_D; const int kb = r / 32, nb = r % 32;
            p0_transpose_item(a.in[which == 0 ? 10 : 20], DFF, DM, nb * 32, 32, (h16*)(ws + (which == 0 ? WS_WD1 : WS_WD2)), nb * 32, kb, scr, F.lane); continue; }
        r -= 2 * I_D;
        if (r < I_IN) { const int kb = r / 136, d = r % 136; int src, nv;
            if (d < 64) { src = 32 * d; nv = 32; } else if (d < 128) { src = C_QR + 32 * (d - 64); nv = 32; } else if (d < 130) { src = C_KI + 32 * (d - 128); nv = 32; } else if (d == 130) { src = C_WI; nv = 8; } else { src = 0; nv = 0; }
            p0_transpose_item(a.in[13], DM, NIN, src, nv, (h16*)(ws + WS_WIN), 32 * d, kb, scr, F.lane); continue; }
        r -= I_IN;
        { const int kb = r / 32, nb = r % 32; p0_transpose_item(a.in[15], DM, DM, nb * 32, 32, (h16*)(ws + WS_WOUT), nb * 32, kb, scr, F.lane); }
    }
    h16* X16 = (h16*)(ws + WS_X16);
    for (int m = gw; m < MR; m += NGW) {
        const float* src = (m < MP) ? a.in[0] + (size_t)m * DM : (m < MV ? a.in[1] + (size_t)(m - MP) * DM : nullptr);
        GAS u32x2* o = (GAS u32x2*)(X16 + (size_t)m * DM) + F.lane;
#pragma unroll
        for (int j = 0; j < 4; ++j) { f32x4 v = src ? ((const GAS f32x4*)src)[F.lane + 64 * j] : (f32x4){0.f, 0.f, 0.f, 0.f}; u32x2 w; w.x = pkh(v[0], v[1]); w.y = pkh(v[2], v[3]); o[64 * j] = w; }
    }
    { float* hf = (float*)(ws + WS_HF); const size_t n4 = (size_t)MR * DM / 4;
      for (size_t i = (size_t)F.vcu * NTHR + F.tid; i < n4; i += (size_t)F.G * NTHR) { const size_t e = i * 4; f32x4 v = (f32x4){0.f, 0.f, 0.f, 0.f};
          if (e < (size_t)MP * DM) v = *(const GAS f32x4*)(a.in[0] + e); else if (e < (size_t)MV * DM) v = *(const GAS f32x4*)(a.in[1] + (e - (size_t)MP * DM));
          *(GAS f32x4*)(hf + e) = v; } }
    f32x2* ROT = (f32x2*)(ws + WS_ROT);
    for (int e = (F.vcu * NTHR + F.tid); e < 4097 * 64; e += F.G * NTHR) {
        const int p = e >> 6, i = e & 63; const float pos = (p < 4096) ? (float)p : 8192.f;
        const float freq = powf(10000.f, -(float)i / 64.f); const float ang = pos * freq;
        ROT[e] = (f32x2){cosf(ang), sinf(ang)};
    }
}

__device__ __forceinline__ void ln_rows(const Frame& F, const float* V, const float* g, const float* b, float* o32, h16* o16, int nrows) {
    const int gw = F.vcu * NWAVES + F.wave, NGW = F.G * NWAVES;
    f32x4 gv[4], bv[4];
#pragma unroll
    for (int j = 0; j < 4; ++j) { gv[j] = ((const GAS f32x4*)g)[F.lane + 64 * j]; bv[j] = ((const GAS f32x4*)b)[F.lane + 64 * j]; }
    for (int m = gw; m < nrows; m += NGW) {
        const GAS f32x4* xr = (const GAS f32x4*)(V + (size_t)m * DM) + F.lane;
        f32x4 v[4]; float s = 0.f;
#pragma unroll
        for (int j = 0; j < 4; ++j) { v[j] = xr[64 * j]; s += (v[j][0] + v[j][1]) + (v[j][2] + v[j][3]); }
        const float mean = wave_sum(s) * (1.f / DM); float s2 = 0.f;
#pragma unroll
        for (int j = 0; j < 4; ++j) { v[j] = v[j] - mean; s2 += (v[j][0] * v[j][0] + v[j][1] * v[j][1]) + (v[j][2] * v[j][2] + v[j][3] * v[j][3]); }
        const float rstd = 1.f / sqrtf(wave_sum(s2) * (1.f / DM) + LN_EPS);
#pragma unroll
        for (int j = 0; j < 4; ++j) { const f32x4 y = v[j] * rstd * gv[j] + bv[j];
            if (o32) ((GAS f32x4*)(o32 + (size_t)m * DM))[F.lane + 64 * j] = y;
            if (o16) { u32x2 w; w.x = pkh(y[0], y[1]); w.y = pkh(y[2], y[3]); ((GAS u32x2*)(o16 + (size_t)m * DM))[F.lane + 64 * j] = w; } }
    }
}

__device__ __forceinline__ int t5_bucket(int n) {
    if (n < 16) return n < 0 ? 0 : n;
    if (n >= 113) return 31;
    const int v = 16 + (int)(log2f((float)n * 0.0625f) * (16.0f / 3.0f));
    return v > 31 ? 31 : v;
}
__device__ __forceinline__ unsigned f2key(float x) { if (x == 0.f) x = 0.f; const unsigned u = __float_as_uint(x); return (u & 0x80000000u) ? ~u : (u | 0x80000000u); }

constexpr int QL_SC = 0;
constexpr int QL_HIST = 32832;
constexpr int QL_LIST = QL_HIST + 1024;
constexpr int QL_PHYS = QL_LIST + 1024;
constexpr int QL_LG = QL_PHYS + 1024;
constexpr int QL_QI = QL_LG + 8192;
constexpr int QL_QA = QL_QI + 2048;
constexpr int QL_BIAS = QL_QA + 2176;
constexpr int QL_MISC = QL_BIAS + 1024;
constexpr int QL_SCAN = QL_MISC + 256;
constexpr int QL_END = QL_SCAN + 2048;
static_assert(QL_END <= RING_BYTES, "query phase LDS");

__device__ __forceinline__ void sample_score_unit(const Frame& F, const Args& a, int unit) {
    unsigned char* ws = a.ws; const int b = unit >> 3, ch = unit & 7; const int row = MP + b; const int tid = opaque(F.tid);
    LAS float* qis = (LAS float*)(F.lds + QL_QI); LAS float* wv_l = (LAS float*)(F.lds + QL_MISC);
    const h16* QI = (const h16*)(ws + WS_QI); const float* WI = (const float*)(ws + WS_WI); float* SSC = (float*)(ws + WS_SSC) + (size_t)b * SSC_PITCH;
    { const int h = tid >> 6, d = tid & 63; qis[d * 8 + h] = h2f(QI[(size_t)row * 512 + tid]) * 0.125f; if (tid < 8) wv_l[tid] = WI[(size_t)row * 8 + tid] * 0.35355339059327373f; }
    __syncthreads();
    float wv[8];
#pragma unroll
    for (int h = 0; h < 8; ++h) wv[h] = wv_l[h];
    const int* pt = a.page_table + b * NPAGES;
    const int nk = (ch == 7) ? 1025 : 1024;
    for (int i = tid; i < nk; i += NTHR) { const int s = ch * 1024 + i;
        const float* kp = (s < PAST) ? a.in[4] + ((size_t)pt[s >> 7] * PAGE + (s & 127)) * 64 : a.out + O_KIS + (size_t)b * 64;
        f32x4 kv[16];
#pragma unroll
        for (int c = 0; c < 16; ++c) kv[c] = *(const GAS f32x4*)(kp + 4 * c);
        float acc[8];
#pragma unroll
        for (int h = 0; h < 8; ++h) acc[h] = 0.f;
        const LAS float* qv = qis; asm volatile("" : "+v"(qv));
#pragma unroll
        for (int c = 0; c < 16; ++c)
#pragma unroll
            for (int e = 0; e < 4; ++e) { const float k0 = kv[c][e]; const int d = 4 * c + e;
                const f32x4 qa0 = *(const LAS f32x4*)(qv + d * 8), qa1 = *(const LAS f32x4*)(qv + d * 8 + 4);
                acc[0] += qa0[0] * k0; acc[1] += qa0[1] * k0; acc[2] += qa0[2] * k0; acc[3] += qa0[3] * k0; acc[4] += qa1[0] * k0; acc[5] += qa1[1] * k0; acc[6] += qa1[2] * k0; acc[7] += qa1[3] * k0; }
        float sco = 0.f;
#pragma unroll
        for (int h = 0; h < 8; ++h) sco += wv[h] * fmaxf(acc[h], 0.f);
        SSC[s] = sco; }
    __syncthreads();
}
__device__ __forceinline__ void sample_attn_unit(const Frame& F, const Args& a, int unit) {
    unsigned char* ws = a.ws; const int b = unit >> 3, h = unit & 7; const int row = MP + b; const int tid = opaque(F.tid), lane = tid & 63, wave = F.wave;
    LAS unsigned* key = (LAS unsigned*)(F.lds + QL_SC); LAS unsigned* hist = (LAS unsigned*)(F.lds + QL_HIST); LAS int* list = (LAS int*)(F.lds + QL_LIST); LAS int* phys = (LAS int*)(F.lds + QL_PHYS);
    LAS float* lg = (LAS float*)(F.lds + QL_LG); LAS float* qas = (LAS float*)(F.lds + QL_QA); LAS unsigned* misc = (LAS unsigned*)(F.lds + QL_MISC); LAS float* red = (LAS float*)(F.lds + QL_SCAN);
    const float* SSC = (const float*)(ws + WS_SSC) + (size_t)b * SSC_PITCH; const int* pt = a.page_table + b * NPAGES; const int n = LS, t = PAST;
    for (int s = tid; s < n; s += NTHR) key[s] = f2key(SSC[s]);
    if (tid < 64) qas[tid] = h2f(((const h16*)(ws + WS_QA))[(size_t)row * 512 + h * 64 + tid]);
    if (tid == 0) misc[2] = 0u;
    __syncthreads();
    unsigned prefix = 0u; int r = TOPK;
#pragma unroll 1
    for (int pass = 0; pass < 4; ++pass) {
        const int shift = 24 - 8 * pass;
        if (tid < 256) hist[tid] = 0u;
        __syncthreads();
        for (int s = tid; s < n; s += NTHR) { const unsigned u = key[s]; if (pass == 0 || (u >> (shift + 8)) == prefix) __hip_atomic_fetch_add(hist + ((u >> shift) & 255u), 1u, __ATOMIC_RELAXED, __HIP_MEMORY_SCOPE_WORKGROUP); }
        __syncthreads();
        if (wave == 0) {
            int c[4]; int local = 0;
#pragma unroll
            for (int j = 0; j < 4; ++j) { c[j] = (int)hist[255 - (4 * lane + j)]; local += c[j]; }
            int incl = local;
#pragma unroll
            for (int o = 1; o < 64; o <<= 1) { const int v = __shfl_up(incl, o); if (lane >= o) incl += v; }
            const int excl = incl - local;
            if (excl < r && r <= incl) { int run = excl;
#pragma unroll
                for (int j = 0; j < 4; ++j) { if (run < r && r <= run + c[j]) { misc[0] = (unsigned)(255 - (4 * lane + j)); misc[1] = (unsigned)(r - run); } run += c[j]; } }
        }
        __syncthreads();
        prefix = (prefix << 8) | misc[0]; r = (int)misc[1];
        __syncthreads();
    }
    { const int chunk = (n + NTHR - 1) / NTHR; const int s0 = tid * chunk, s1 = (s0 + chunk < n) ? s0 + chunk : n;
      int neq = 0;
      for (int s = s0; s < s1; ++s) neq += (key[s] == prefix) ? 1 : 0;
      int incl = neq;
#pragma unroll
      for (int o = 1; o < 64; o <<= 1) { const int v = __shfl_up(incl, o); if (lane >= o) incl += v; }
      if (lane == 63) misc[16 + wave] = (unsigned)incl;
      __syncthreads();
      int ord = incl - neq;
      for (int w = 0; w < wave; ++w) ord += (int)misc[16 + w];
      for (int s = s0; s < s1; ++s) { const unsigned u = key[s]; bool take = u > prefix; if (u == prefix) { take = ord < r; ++ord; }
          if (take) { const unsigned p = __hip_atomic_fetch_add(misc + 2, 1u, __ATOMIC_RELAXED, __HIP_MEMORY_SCOPE_WORKGROUP); if (p < TOPK) list[p] = s; } } }
    __syncthreads();
    if (tid < TOPK) { const int s = list[tid]; phys[tid] = (s >= PAST) ? -1 : pt[s >> 7] * PAGE + (s & 127); }
    __syncthreads();
    { const int k = tid >> 1, half = tid & 1; const int pr = phys[k];
      const float* kp = ((pr < 0) ? a.out + O_KS + (size_t)b * 512 : a.in[2] + (size_t)pr * 512) + h * 64 + half * 32;
      f32x4 kv[8];
#pragma unroll
      for (int c = 0; c < 8; ++c) kv[c] = *(const GAS f32x4*)(kp + 4 * c);
      float dot = 0.f;
#pragma unroll
      for (int c = 0; c < 8; ++c) { const f32x4 q = *(const LAS f32x4*)(qas + half * 32 + 4 * c); dot += q[0] * kv[c][0] + q[1] * kv[c][1] + q[2] * kv[c][2] + q[3] * kv[c][3]; }
      dot += __shfl_xor(dot, 1);
      if (half == 0) lg[k] = dot * 0.6931471805599453f + a.in[7][t5_bucket(t - list[k]) * 8 + h]; }
    __syncthreads();
    { float v[4]; float mx = -INFINITY;
#pragma unroll
      for (int j = 0; j < 4; ++j) { v[j] = lg[lane + 64 * j]; mx = fmaxf(mx, v[j]); }
      mx = wave_max(mx); float sm = 0.f;
#pragma unroll
      for (int j = 0; j < 4; ++j) { v[j] = __expf(v[j] - mx); sm += v[j]; }
      sm = wave_sum(sm); const float inv = 1.f / sm;
      __syncthreads();
      if (wave == 0) {
#pragma unroll
          for (int j = 0; j < 4; ++j) lg[lane + 64 * j] = v[j] * inv; } }
    __syncthreads();
    { const int d = tid & 63, g = tid >> 6; float o = 0.f;
#pragma unroll 8
      for (int kk = 0; kk < 32; ++kk) { const int k = g * 32 + kk; const int pr = phys[k];
          const float* vp = (pr < 0) ? a.out + O_VS + (size_t)b * 512 : a.in[3] + (size_t)pr * 512;
          o += lg[k] * vp[h * 64 + d]; }
      red[g * 64 + d] = o;
      __syncthreads();
      if (tid < 64) { float t8 = 0.f;
#pragma unroll
          for (int g2 = 0; g2 < 8; ++g2) t8 += red[g2 * 64 + tid];
          ((h16*)(ws + WS_MIX))[(size_t)row * DM + h * 64 + tid] = f2h(t8); } }
    __syncthreads();
}

typedef float f32x16 __attribute__((ext_vector_type(16)));
constexpr int SEL_ROW = 16384, SEL_HIST = 1024, SEL_WAVE = WORK_BYTES / 8, SEL_CAP = (SEL_WAVE - SEL_ROW) / 8;
static_assert(SEL_CAP >= 192 && SEL_CAP <= 256, "candidate capacity");
static_assert(8 * SEL_WAVE <= WORK_BYTES, "selection LDS");
__device__ __forceinline__ int sel_bucket(float x, float mn, float scale) { return (int)fminf((x - mn) * scale, 511.0f); }
__device__ __forceinline__ unsigned long long sel_comp(float x, int s) { return ((unsigned long long)f2key(x) << 32) | (unsigned long long)(0xFFFFFFFFu - (unsigned)s); }
__device__ __forceinline__ void select_row(const float* rp, int n, float mn, float mx, LAS unsigned char* wl, unsigned long long* mrow, int lane) {
    LAS float* xr = (LAS float*)wl; LAS unsigned* hist = (LAS unsigned*)(wl + SEL_ROW); LAS unsigned long long* cand = (LAS unsigned long long*)(wl + SEL_ROW);
    const int nfull = n >> 6, rem = n & 63;
    const float scale = (mx > mn) ? fminf(512.0f / (mx - mn), 1e30f) : 0.f;
#pragma unroll
    for (int k = 0; k < 4; ++k) hist[4 * lane + k] = 0u;
#define SELA(J, X) do { const float x_ = (X) + 0.f; xr[64 * (J) + lane] = x_; const int bk_ = sel_bucket(x_, mn, scale); \
        __hip_atomic_fetch_add(hist + (bk_ >> 1), 1u << (16 * (bk_ & 1)), __ATOMIC_RELAXED, __HIP_MEMORY_SCOPE_WORKGROUP); } while (0)
    { int j = 0;
      for (; j + 16 <= nfull; j += 16) { float xv[16];
#pragma unroll
          for (int u = 0; u < 16; ++u) xv[u] = rp[64 * (j + u) + lane];
#pragma unroll
          for (int u = 0; u < 16; ++u) SELA(j + u, xv[u]); }
      for (; j + 4 <= nfull; j += 4) { float xv[4];
#pragma unroll
          for (int u = 0; u < 4; ++u) xv[u] = rp[64 * (j + u) + lane];
#pragma unroll
          for (int u = 0; u < 4; ++u) SELA(j + u, xv[u]); }
      for (; j < nfull; ++j) { const float xv = rp[64 * j + lane]; SELA(j, xv); }
      if (rem) { if (lane < rem) { const float xv = rp[64 * nfull + lane]; SELA(nfull, xv); } } }
#undef SELA
    int c[8]; int local = 0;
#pragma unroll
    for (int k = 0; k < 4; ++k) { const unsigned w = hist[255 - 4 * lane - k]; c[2 * k] = (int)(w >> 16); c[2 * k + 1] = (int)(w & 0xffffu); local += c[2 * k] + c[2 * k + 1]; }
    int incl = local;
#pragma unroll
    for (int o = 1; o < 64; o <<= 1) { const int v = __shfl_up(incl, o); if (lane >= o) incl += v; }
    const int excl = incl - local;
    int bs_l = 0, r_l = 0; { int run = excl;
#pragma unroll
        for (int i = 0; i < 8; ++i) { if (run < TOPK && TOPK <= run + c[i]) { bs_l = 511 - 8 * lane - i; r_l = TOPK - run; } run += c[i]; } }
    const unsigned long long hitb = __ballot(excl < TOPK && TOPK <= incl);
    const int src = hitb ? __builtin_ctzll(hitb) : 0;
    const int bstar = __shfl(bs_l, src), r = __shfl(r_l, src);
    asm volatile("" ::: "memory");
    int m = 0; unsigned long long myw = 0ull;
#define SELB(J, X, VALID) do { const float x_ = (X); const int bk_ = sel_bucket(x_, mn, scale); \
        const unsigned long long bg_ = __ballot((VALID) && bk_ > bstar); if (lane == (J)) myw = bg_; \
        const bool eq_ = (VALID) && bk_ == bstar; const unsigned long long be_ = __ballot(eq_); \
        if (be_) { const int pos_ = m + __builtin_popcountll(be_ & ((1ull << lane) - 1ull)); if (eq_ && pos_ < SEL_CAP) cand[pos_] = sel_comp(x_, 64 * (J) + lane); m += __builtin_popcountll(be_); } } while (0)
    { int j = 0;
      for (; j + 8 <= nfull; j += 8) { float xv[8];
#pragma unroll
          for (int u = 0; u < 8; ++u) xv[u] = xr[64 * (j + u) + lane];
#pragma unroll
          for (int u = 0; u < 8; ++u) SELB(j + u, xv[u], true); }
      for (; j < nfull; ++j) { const float xv = xr[64 * j + lane]; SELB(j, xv, true); }
      if (rem) { const float xv = xr[64 * nfull + lane]; SELB(nfull, xv, lane < rem); } }
#undef SELB
    unsigned long long T = 0ull;
    if (m <= SEL_CAP) {
        unsigned long long ci[4]; int rank[4];
#pragma unroll
        for (int q = 0; q < 4; ++q) { ci[q] = (lane + 64 * q < m) ? cand[lane + 64 * q] : 0ull; rank[q] = 0; }
        for (int j = 0; j < m; ++j) { const unsigned long long cj = cand[j];
#pragma unroll
            for (int q = 0; q < 4; ++q) rank[q] += (cj > ci[q]) ? 1 : 0; }
#pragma unroll
        for (int q = 0; q < 4; ++q) { const unsigned long long hb = __ballot(lane + 64 * q < m && rank[q] == r - 1);
            if (hb) { const int sl = __builtin_ctzll(hb); T = ((unsigned long long)(unsigned)__shfl((int)(unsigned)(ci[q] >> 32), sl) << 32) | (unsigned long long)(unsigned)__shfl((int)(unsigned)ci[q], sl); } }
        asm volatile("" ::: "memory");
        LAS unsigned* mw32 = (LAS unsigned*)(wl + SEL_ROW);
        mw32[2 * lane] = (unsigned)myw; mw32[2 * lane + 1] = (unsigned)(myw >> 32);
#pragma unroll
        for (int q = 0; q < 4; ++q) if (lane + 64 * q < m && ci[q] >= T) { const unsigned sidx = 0xFFFFFFFFu - (unsigned)ci[q]; __hip_atomic_fetch_or(mw32 + (sidx >> 5), 1u << (sidx & 31u), __ATOMIC_RELAXED, __HIP_MEMORY_SCOPE_WORKGROUP); }
        asm volatile("" ::: "memory");
        myw = (unsigned long long)mw32[2 * lane] | ((unsigned long long)mw32[2 * lane + 1] << 32);
    } else {
        const int nj = (n + 63) >> 6;
        for (int bit = 63; bit >= 0; --bit) { const unsigned long long tt = T | (1ull << bit); int cntge = 0;
            for (int j = 0; j < nj; ++j) { const int s = 64 * j + lane; const float x = xr[s]; const bool ge = (s < n) && sel_bucket(x, mn, scale) == bstar && sel_comp(x, s) >= tt; cntge += __builtin_popcountll(__ballot(ge)); }
            if (cntge >= r) T = tt; }
        for (int j = 0; j < nj; ++j) { const int s = 64 * j + lane; const float x = xr[s]; const bool sel = (s < n) && sel_bucket(x, mn, scale) == bstar && sel_comp(x, s) >= T;
            const unsigned long long bal = __ballot(sel); if (lane == j) myw |= bal; }
    }
    mrow[lane] = myw;
}
__device__ __forceinline__ void idx_unit(const Frame& F, const Args& a, int b, int qb) {
    unsigned char* ws = a.ws; const int lane = opaque(F.lane), w = F.wave, r = lane & 31, hp = lane >> 5;
    const h16* QI = (const h16*)(ws + WS_QI); const h16* KI = (const h16*)(ws + WS_KI); const float* WI = (const float*)(ws + WS_WI);
    float* SCORE = (float*)(ws + WS_SCORE); unsigned long long* MASK = (unsigned long long*)(ws + WS_MASK);
    const size_t rowb = (size_t)b * SEQ; const int t0 = 32 * qb + 4 * w;
    const int q4 = ((r >> 4) & 1) + 2 * ((r >> 2) & 1), hd = (r & 3) + 4 * ((r >> 3) & 1);
    const h16* qp = QI + (rowb + t0 + q4) * 512 + hd * 64 + 8 * hp;
    f16x8 af[4];
#pragma unroll
    for (int ks = 0; ks < 4; ++ks) af[ks] = __builtin_bit_cast(f16x8, *(const GAS s16x8*)(qp + 16 * ks));
    float wA[8], wB[8]; { const float* wp = WI + (rowb + t0 + 2 * hp) * 8; const float cc = 0.35355339059327373f * 0.125f;
#pragma unroll
        for (int g = 0; g < 8; ++g) { wA[g] = wp[g] * cc; wB[g] = wp[8 + g] * cc; } }
    float* sA = SCORE + (rowb + t0 + 2 * hp) * SEQ + r; float* sB = sA + SEQ;
    const h16* kp = KI + (rowb + r) * 64 + 8 * hp;
    f16x8 bf[4][4];
#define IDX_LD(slot, kt_) do { const h16* kq_ = kp + (size_t)(((kt_) < qb) ? (kt_) : qb) * 32 * 64; \
        _Pragma("unroll") for (int ks = 0; ks < 4; ++ks) bf[slot][ks] = __builtin_bit_cast(f16x8, *(const GAS s16x8*)(kq_ + 16 * ks)); } while (0)
#define IDX_MM(slot, kt_) do { f32x16 acc; _Pragma("unroll") for (int g = 0; g < 16; ++g) acc[g] = 0.f; \
        _Pragma("unroll") for (int ks = 0; ks < 4; ++ks) acc = __builtin_amdgcn_mfma_f32_32x32x16_f16(af[ks], bf[slot][ks], acc, 0, 0, 0); \
        float sa = 0.f, sb = 0.f; \
        _Pragma("unroll") for (int g = 0; g < 8; ++g) { sa += wA[g] * fmaxf(acc[g], 0.f); sb += wB[g] * fmaxf(acc[8 + g], 0.f); } \
        sA[32 * (kt_)] = sa; sB[32 * (kt_)] = sb; mnA = fminf(mnA, sa); mxA = fmaxf(mxA, sa); mnB = fminf(mnB, sb); mxB = fmaxf(mxB, sb); } while (0)
    float mnA = INFINITY, mxA = -INFINITY, mnB = INFINITY, mxB = -INFINITY;
    IDX_LD(0, 0); IDX_LD(1, 1); IDX_LD(2, 2); IDX_LD(3, 3);
    for (int kt = 0; kt <= qb; kt += 4) {
        IDX_MM(0, kt); IDX_LD(0, kt + 4);
        if (kt + 1 <= qb) { IDX_MM(1, kt + 1); } IDX_LD(1, kt + 5);
        if (kt + 2 <= qb) { IDX_MM(2, kt + 2); } IDX_LD(2, kt + 6);
        if (kt + 3 <= qb) { IDX_MM(3, kt + 3); } IDX_LD(3, kt + 7);
    }
#undef IDX_LD
#undef IDX_MM
#pragma unroll
    for (int o = 1; o < 32; o <<= 1) { mnA = fminf(mnA, __shfl_xor(mnA, o)); mxA = fmaxf(mxA, __shfl_xor(mxA, o)); mnB = fminf(mnB, __shfl_xor(mnB, o)); mxB = fmaxf(mxB, __shfl_xor(mxB, o)); }
    VM_WAIT();
    LAS unsigned char* wl = F.lds + w * SEL_WAVE;
    for (int i = 0; i < 4; ++i) { const int t = t0 + i, n = t + 1; unsigned long long* mrow = MASK + (rowb + t) * 64;
        const float mn = __shfl((i & 1) ? mnB : mnA, (i >> 1) * 32), mx = __shfl((i & 1) ? mxB : mxA, (i >> 1) * 32);
        if (n > TOPK) select_row(SCORE + (rowb + t) * SEQ, n, mn, mx, wl, mrow, lane);
        else { const int j = lane; unsigned long long wv = 0ull; if (64 * j + 64 <= n) wv = ~0ull; else if (64 * j < n) wv = (1ull << (n - 64 * j)) - 1ull; mrow[lane] = wv; } }
}


namespace attn_body {
using bf16x8 = __attribute__((ext_vector_type(8))) short;
using s16x4 = __attribute__((ext_vector_type(4))) short;
using u32x4 = __attribute__((ext_vector_type(4))) unsigned;
constexpr int NHEAD = 8, SEQL = 4096, D = 64, PQ = 512, PO = 1024;
constexpr int NW = 8, QBLK = 32, QB = QBLK * NW, KVBLK = 64;
__device__ __forceinline__ int crow(int r, int hi) { return (r & 3) + 8 * (r >> 2) + 4 * hi; }
#define SBAR() __builtin_amdgcn_sched_barrier(0)
constexpr int NSLOT = 3, SLOTB = 8192;
constexpr int LDS_K = 0, LDS_V = NSLOT * SLOTB, LDS_WS = 2 * NSLOT * SLOTB, LDS_OST = LDS_WS + NW * 64 * 4, LDS_BT = LDS_OST + NW * 4096, LDS_BYTES = LDS_BT + 512;
constexpr float LOG2E = 1.4426950408889634f;
constexpr float C2 = 0.125f * LOG2E;
__device__ __forceinline__ void glds16(const void* gbase  , unsigned voff, unsigned lds_dst) { unsigned keep;
    asm volatile("s_mov_b32 %0, m0\n\ts_mov_b32 m0, %2\n\ts_nop 0\n\tglobal_load_lds_dwordx4 %1, %3\n\ts_mov_b32 m0, %0" : "=&s"(keep) : "v"(voff), "s"(lds_dst), "s"(gbase) : "memory"); }
__device__ __forceinline__ float max3f(float a, float b, float c) { float r; asm("v_max3_f32 %0, %1, %2, %3" : "=v"(r) : "v"(a), "v"(b), "v"(c)); return r; }
__device__ __forceinline__ float max2f(float a, float b) { float r; asm("v_max_f32_e32 %0, %1, %2" : "=v"(r) : "v"(a), "v"(b)); return r; }
__device__ __forceinline__ float fadd_s(float a, float b) { float r; asm("v_add_f32_e32 %0, %1, %2" : "=v"(r) : "v"(a), "v"(b)); return r; }
__device__ __forceinline__ float fsub_s(float a, float b) { float r; asm("v_sub_f32_e32 %0, %1, %2" : "=v"(r) : "v"(a), "v"(b)); return r; }
typedef __bf16 bf16x2_t __attribute__((ext_vector_type(2)));
__device__ __forceinline__ unsigned cvtpk_s(float lo, float hi) { f32x2 v = {lo, hi}; bf16x2_t b = __builtin_convertvector(v, bf16x2_t); return __builtin_bit_cast(unsigned, b); }
#define WAIT_BAR(N) asm volatile("s_waitcnt vmcnt(" #N ") lgkmcnt(0)\n\ts_barrier" ::: "memory")
#define MFQK(a, b, c) __builtin_amdgcn_mfma_f32_32x32x16_f16(__builtin_bit_cast(f16x8, a), __builtin_bit_cast(f16x8, b), c, 0, 0, 0)
#define MFPV(a, b, c) __builtin_amdgcn_mfma_f32_32x32x16_bf16(a, b, c, 0, 0, 0)
#define MSK(v, mw, bp) __uint_as_float(__float_as_uint(v) & (unsigned)(((int)((mw) << (31 - (bp)))) >> 31))
#define BP(e) (((e) & 3) + 8 * ((e) >> 2))

__device__ __forceinline__ void qkt(f32x16& p0, f32x16& p1, const char* Kslot, const bf16x8* qr, int r32, int hi) {
    const char* kb = Kslot + hi * 1024 + r32 * 16;
#pragma unroll
    for (int d0 = 0; d0 < 4; ++d0) {
        const bf16x8 b0 = *reinterpret_cast<const bf16x8*>(kb + d0 * 2048);
        const bf16x8 b1 = *reinterpret_cast<const bf16x8*>(kb + d0 * 2048 + 512);
        if (d0 == 0) { p0 = MFQK(b0, qr[0], f32x16{}); p1 = MFQK(b1, qr[0], f32x16{}); }
        else { p0 = MFQK(b0, qr[d0], p0); p1 = MFQK(b1, qr[d0], p1); } }
}
typedef __attribute__((address_space(3))) const char* lds_cptr;
typedef short v4i16_t __attribute__((ext_vector_type(4)));
__device__ __forceinline__ void kload8(bf16x8* kf, lds_cptr kp) {
    kf[0] = *(const LAS bf16x8*)(kp);        kf[1] = *(const LAS bf16x8*)(kp + 512);
    kf[2] = *(const LAS bf16x8*)(kp + 2048); kf[3] = *(const LAS bf16x8*)(kp + 2560);
    kf[4] = *(const LAS bf16x8*)(kp + 4096); kf[5] = *(const LAS bf16x8*)(kp + 4608);
    kf[6] = *(const LAS bf16x8*)(kp + 6144); kf[7] = *(const LAS bf16x8*)(kp + 6656);
}
__device__ __forceinline__ void kload2(bf16x8* kf, lds_cptr kp, int j) { kf[2 * j] = *(const LAS bf16x8*)(kp + j * 2048); kf[2 * j + 1] = *(const LAS bf16x8*)(kp + j * 2048 + 512); }
__device__ __forceinline__ s16x4 vtr(lds_cptr p) { return __builtin_bit_cast(s16x4, __builtin_amdgcn_ds_read_tr16_b64_v4i16((LAS v4i16_t*)p)); }
__device__ __forceinline__ float rowmax(const f32x16& p0, const f32x16& p1) {
    float a = max3f(p0[0], p0[1], p1[0]), b = max3f(p0[2], p0[3], p1[1]); a = max3f(a, p1[2], p1[3]);
#pragma unroll
    for (int r = 4; r < 16; r += 4) { a = max3f(a, p0[r], p0[r + 1]); b = max3f(b, p0[r + 2], p0[r + 3]); a = max3f(a, p1[r], p1[r + 1]); b = max3f(b, p1[r + 2], p1[r + 3]); }
    const float m = max2f(a, b);
    auto rr = __builtin_amdgcn_permlane32_swap(__float_as_uint(m), __float_as_uint(m), false, false);
    return max2f(__uint_as_float(rr[0]), __uint_as_float(rr[1]));
}
__device__ __forceinline__ void pv(f32x16* o, int vb, bf16x8 pa0, bf16x8 pa1, bf16x8 pa2, bf16x8 pa3) {
#pragma unroll
    for (int d0 = 0; d0 < 2; ++d0) { s16x4 lo[4], hi[4];
#pragma unroll
        for (int ks = 0; ks < 4; ++ks) {
            asm volatile("ds_read_b64_tr_b16 %0,%1 offset:%c2" : "=&v"(lo[ks]) : "v"(vb), "i"(d0 * 4096 + ks * 1024) : "memory");
            asm volatile("ds_read_b64_tr_b16 %0,%1 offset:%c2" : "=&v"(hi[ks]) : "v"(vb), "i"(d0 * 4096 + ks * 1024 + 512) : "memory"); }
        asm volatile("s_waitcnt lgkmcnt(0)" ::: "memory"); SBAR();
#define PK(k) (bf16x8){lo[k][0], lo[k][1], lo[k][2], lo[k][3], hi[k][0], hi[k][1], hi[k][2], hi[k][3]}
        o[d0] = MFPV(pa0, PK(0), o[d0]); o[d0] = MFPV(pa1, PK(1), o[d0]); o[d0] = MFPV(pa2, PK(2), o[d0]); o[d0] = MFPV(pa3, PK(3), o[d0]);
#undef PK
    }
}
template <int THRL> __device__ __forceinline__ void attn_unit(int b, int h, int qb, const h16* Q, const h16* __restrict__ K, const h16* __restrict__ V, h16* O,
                                                               const unsigned long long* MASK, const float* relb, char* shm) {
    int tid_ = threadIdx.x; asm volatile("" : "+v"(tid_));
    const int tid = tid_, lane = tid & 63, r32 = lane & 31, hi = lane >> 5; const int wid = __builtin_amdgcn_readfirstlane(tid >> 6);
    const long rowbase = (long)b * SEQL; const int q0 = qb * QB;
    const h16* Qw = Q + (rowbase + q0 + wid * QBLK) * PQ + h * D;
    const h16 *Kh = K + rowbase * PQ + h * D, *Vh = V + rowbase * PQ + h * D;
    const unsigned lds0 = (unsigned)(uintptr_t)shm;
    float* wsf = (float*)(shm + LDS_WS) + wid * 64;
    const LAS float* bt = (const LAS float*)((lds_cptr)shm + LDS_BT);
    const unsigned kvo = (unsigned)(lane * PQ + wid * 8) * 2u;
    const unsigned vvo = (unsigned)((16 * (wid & 3) + (lane >> 2)) * PQ + (wid >> 2) * 32 + (lane & 3) * 8) * 2u;
    const unsigned kdst = lds0 + LDS_K + wid * 1024, vdst = lds0 + LDS_V + wid * 1024;
#define DMA_K(t, slot) glds16(Kh + (long)(t) * KVBLK * PQ, kvo, (unsigned)__builtin_amdgcn_readfirstlane(kdst + (slot)))
#define DMA_V(t, slot) glds16(Vh + (long)(t) * KVBLK * PQ, vvo, (unsigned)__builtin_amdgcn_readfirstlane(vdst + (slot)))
    const int vb0 = (int)(lds0 + LDS_V) + ((lane >> 4) & 1) * 32 + (lane & 3) * 8 + (4 * hi + ((lane & 15) >> 2)) * 64;
    const char* Kbase = shm + LDS_K; bf16x8 kf[8];
    const lds_cptr shm3 = (lds_cptr)shm; const lds_cptr kp0 = shm3 + LDS_K + hi * 1024 + r32 * 16; const lds_cptr vp0 = shm3 + LDS_V + ((lane >> 4) & 1) * 32 + (lane & 3) * 8 + (4 * hi + ((lane & 15) >> 2)) * 64;
    const int NT = (q0 + QB) / KVBLK;
    DMA_K(0, 0); DMA_V(0, 0); DMA_K(1, SLOTB);
    const float c31l = relb[31 * 8 + h] * LOG2E;
    if (tid < 128) ((LAS float*)((LAS char*)shm3 + LDS_BT))[tid] = relb[t5_bucket(tid) * 8 + h] * LOG2E - c31l;
    bf16x8 qr[4];
#pragma unroll
    for (int d0 = 0; d0 < 4; ++d0) qr[d0] = *(const GAS bf16x8*)((const GAS char*)Qw + (unsigned)(r32 * PQ + d0 * 16 + hi * 8) * 2u);
    const int qabs = q0 + wid * QBLK + r32;
    const unsigned moff = (unsigned)(rowbase + qabs) * 512u;
#define MROW(t) (*(const GAS unsigned long long*)((const GAS char*)MASK + (moff + 8u * (unsigned)(t))))
    float nm = 0.f, l_reg = 0.f; f32x16 o[2]; o[0] = f32x16{}; o[1] = f32x16{};
#define BIASB(P0, P1, t) do { const int jb_ = (t) - (NT - 6); if (jb_ >= 0) { const int db_ = qabs - 64 * (t) - 4 * hi; \
        _Pragma("unroll") for (int r = 0; r < 16; ++r) { const int d0_ = db_ - BP(r); const int da_ = d0_ < 0 ? 0 : (d0_ > 127 ? 127 : d0_); const int d1_ = d0_ - 32; const int db2_ = d1_ < 0 ? 0 : (d1_ > 127 ? 127 : d1_); \
            P0[r] += bt[da_]; P1[r] += bt[db2_]; } } } while (0)
    bool resc = false;
#define START(P0, P1) do { const float rm = rowmax(P0, P1); resc = false; nm = -rm; \
    _Pragma("unroll") for (int r = 0; r < 16; ++r) P0[r] = MSK(__builtin_amdgcn_exp2f(P0[r] + nm), mlo, BP(r)); } while (0)
#define RESC() do { if (resc) { asm volatile("s_waitcnt lgkmcnt(0)" ::: "memory"); \
      _Pragma("unroll") for (int d_ = 0; d_ < 2; ++d_) _Pragma("unroll") for (int r = 0; r < 16; ++r) o[d_][r] *= wsf[crow(r, hi)]; } } while (0)
    f32x16 pA0, pA1, pB0, pB1;
    int sl_prev = 0, sl_cur = 0, sl_next = SLOTB;
#define ROT() do { sl_prev = sl_cur; sl_cur = sl_next; sl_next = (sl_next == (NSLOT - 1) * SLOTB) ? 0 : sl_next + SLOTB; } while (0)
    DMA_K(2, 2 * SLOTB);
    unsigned mlo, mhi; { const unsigned long long mw = MROW(0); mlo = (unsigned)mw >> (4 * hi); mhi = (unsigned)(mw >> 32) >> (4 * hi); }
    WAIT_BAR(3);
    qkt(pA0, pA1, Kbase, qr, r32, hi); asm volatile("s_nop 15\n\ts_nop 7" : "+v"(pA0), "+v"(pA1)); BIASB(pA0, pA1, 0);
    START(pA0, pA1);
    _Pragma("unroll") for (int r = 0; r < 16; ++r) pA1[r] = MSK(__builtin_amdgcn_exp2f(pA1[r] + nm), mhi, BP(r));
    WAIT_BAR(0);
    DMA_K(3, 0); DMA_V(1, SLOTB);
    ROT();
    kload8(kf, kp0 + sl_cur);
    WAIT_BAR(2);
    s16x4 vlo[8], vhi[8]; u32x4 pw0, pw1, pw2, pw3;
#define PKW(P, B) cvtpk_s(P[B], P[B + 1])
#define PAF(k) __builtin_bit_cast(bf16x8, pw##k)
#define VFR(i) (bf16x8){vlo[i][0], vlo[i][1], vlo[i][2], vlo[i][3], vhi[i][0], vhi[i][1], vhi[i][2], vhi[i][3]}
#define PIN(x) asm volatile("" : "+v"(x))
#define MX3(a, b, c) __builtin_fmaxf(__builtin_fmaxf((a), (b)), (c))
#define GAPA(MF, A0, A1, A2, A3, W0, W1, PW) do { MF; sacc += A0; sacc += A1; sacc += A2; sacc += A3; PIN(sacc); W0; W1; PIN(PW); SBAR(); } while (0)
#define EX(v) __builtin_amdgcn_exp2f(v)
#define GAPB(MF, X, B, MW) do { MF; X[B] = MSK(EX(X[B] + nm), MW, BP(B)); X[B + 1] = MSK(EX(X[B + 1] + nm), MW, BP(B + 1)); X[B + 2] = MSK(EX(X[B + 2] + nm), MW, BP(B + 2)); X[B + 3] = MSK(EX(X[B + 3] + nm), MW, BP(B + 3)); PIN(X); SBAR(); } while (0)
#define VRD(i) do { vlo[i] = vtr(vp_ + (((i) >> 2) * 4096 + ((i) & 3) * 1024)); vhi[i] = vtr(vp_ + (((i) >> 2) * 4096 + ((i) & 3) * 1024 + 512)); } while (0)
#define KRD(G, j) do { if (G) { kload2(kf, kp0 + sl_next, j); SBAR(); } } while (0)
#define STEP(C0, C1, P0, P1, t, GK, GV, GL) do { SBAR(); \
    const lds_cptr vp_ = vp0 + sl_prev; \
    { const unsigned long long mw_ = MROW(t); mlo = (unsigned)mw_ >> (4 * hi); mhi = (unsigned)(mw_ >> 32) >> (4 * hi); } \
    VRD(0); SBAR(); float sacc = (P0[0] + P0[1]); \
    GAPA(C0 = MFQK(kf[0], qr[0], f32x16{}), P0[2], P0[3], P0[4], P0[5],     pw0[0] = PKW(P0, 0), pw0[1] = PKW(P0, 2), pw0); \
    VRD(4); SBAR(); GAPA(C1 = MFQK(kf[1], qr[0], f32x16{}), P0[6], P0[7], P0[8], P0[9],     pw0[2] = PKW(P0, 4), pw0[3] = PKW(P0, 6), pw0); \
    VRD(1); SBAR(); GAPA(C0 = MFQK(kf[2], qr[1], C0),   P0[10], P0[11], P0[12], P0[13], pw1[0] = PKW(P0, 8), pw1[1] = PKW(P0, 10), pw1); \
    VRD(5); SBAR(); GAPA(C1 = MFQK(kf[3], qr[1], C1),   P0[14], P0[15], P1[0], P1[1],   pw1[2] = PKW(P0, 12), pw1[3] = PKW(P0, 14), pw1); \
    VRD(2); SBAR(); GAPA(C0 = MFQK(kf[4], qr[2], C0),   P1[2], P1[3], P1[4], P1[5],     pw2[0] = PKW(P1, 0), pw2[1] = PKW(P1, 2), pw2); \
    VRD(6); SBAR(); GAPA(C1 = MFQK(kf[5], qr[2], C1),   P1[6], P1[7], P1[8], P1[9],     pw2[2] = PKW(P1, 4), pw2[3] = PKW(P1, 6), pw2); \
    VRD(3); SBAR(); GAPA(C0 = MFQK(kf[6], qr[3], C0),   P1[10], P1[11], P1[12], P1[13], pw3[0] = PKW(P1, 8), pw3[1] = PKW(P1, 10), pw3); \
    VRD(7); SBAR(); GAPA(C1 = MFQK(kf[7], qr[3], C1),   P1[14], P1[15], 0.f, 0.f,       pw3[2] = PKW(P1, 12), pw3[3] = PKW(P1, 14), pw3); \
    l_reg += sacc; \
    if (GK) { DMA_K((t) + 3, sl_cur); } if (GV) { DMA_V((t) + 1, sl_next); } \
    BIASB(C0, C1, t); \
    { float a = MX3(C0[0], C0[1], C1[0]), b = MX3(C0[2], C0[3], C1[1]); a = MX3(a, C1[2], C1[3]); \
      _Pragma("unroll") for (int r = 4; r < 16; r += 4) { a = MX3(a, C0[r], C0[r + 1]); b = MX3(b, C0[r + 2], C0[r + 3]); a = MX3(a, C1[r], C1[r + 1]); b = MX3(b, C1[r + 2], C1[r + 3]); } \
      float rm = __builtin_fmaxf(a, b); { auto rr = __builtin_amdgcn_permlane32_swap(__float_as_uint(rm), __float_as_uint(rm), false, false); rm = __builtin_fmaxf(__uint_as_float(rr[0]), __uint_as_float(rr[1])); } \
      resc = false; \
      rm += nm; \
      if (__builtin_expect(__any(rm > (float)THRL), 0)) { const float dl = __builtin_fmaxf(rm, 0.f); nm -= dl; \
        const float f = __builtin_amdgcn_exp2f(-dl); l_reg *= f; if (hi == 0) wsf[r32] = f; resc = true; } } \
    SBAR(); \
    GAPB(o[0] = MFPV(PAF(0), VFR(0), o[0]), C0, 0, mlo); \
    GAPB(o[1] = MFPV(PAF(0), VFR(4), o[1]), C0, 4, mlo); \
    KRD(GL, 0); GAPB(o[0] = MFPV(PAF(1), VFR(1), o[0]), C0, 8, mlo); \
    KRD(GL, 1); GAPB(o[1] = MFPV(PAF(1), VFR(5), o[1]), C0, 12, mlo); \
    KRD(GL, 2); GAPB(o[0] = MFPV(PAF(2), VFR(2), o[0]), C1, 0, mhi); \
    KRD(GL, 3); GAPB(o[1] = MFPV(PAF(2), VFR(6), o[1]), C1, 4, mhi); \
    GAPB(o[0] = MFPV(PAF(3), VFR(3), o[0]), C1, 8, mhi); \
    GAPB(o[1] = MFPV(PAF(3), VFR(7), o[1]), C1, 12, mhi); \
    } while (0)
    int t = 1;
    for (; t + 7 < NT; t += 2) {
        STEP(pB0, pB1, pA0, pA1, t, true, true, true);     WAIT_BAR(2); RESC(); ROT();
        STEP(pA0, pA1, pB0, pB1, t + 1, true, true, true); WAIT_BAR(2); RESC(); ROT();
    }
#define ENDW(tt) do { if ((tt) + 3 < NT) { WAIT_BAR(2); } else if ((tt) + 2 < NT) { WAIT_BAR(1); } else { WAIT_BAR(0); } } while (0)
    for (; t + 1 < NT; t += 2) {
        STEP(pB0, pB1, pA0, pA1, t, (t + 3 < NT), (t + 1 < NT), (t + 1 < NT));       ENDW(t);     RESC(); ROT();
        STEP(pA0, pA1, pB0, pB1, t + 1, (t + 4 < NT), (t + 2 < NT), (t + 2 < NT));   ENDW(t + 1); RESC(); ROT();
    }
    STEP(pB0, pB1, pA0, pA1, NT - 1, false, false, false); RESC();
    { float sacc = pB0[0] + pB0[1]; _Pragma("unroll") for (int r = 2; r < 16; ++r) sacc += pB0[r]; _Pragma("unroll") for (int r = 0; r < 16; ++r) sacc += pB1[r]; l_reg += sacc;
      pw0 = (u32x4){PKW(pB0, 0), PKW(pB0, 2), PKW(pB0, 4), PKW(pB0, 6)}; pw1 = (u32x4){PKW(pB0, 8), PKW(pB0, 10), PKW(pB0, 12), PKW(pB0, 14)}; pw2 = (u32x4){PKW(pB1, 0), PKW(pB1, 2), PKW(pB1, 4), PKW(pB1, 6)}; pw3 = (u32x4){PKW(pB1, 8), PKW(pB1, 10), PKW(pB1, 12), PKW(pB1, 14)};
      SBAR(); pv(o, vb0 + sl_cur, PAF(0), PAF(1), PAF(2), PAF(3)); }
#undef PKW
#undef PAF
#undef VFR
#undef PIN
#undef MX3
#undef GAPA
#undef GAPB
#undef EX
#undef VRD
#undef KRD
#undef STEP
#undef ENDW
    { auto rr = __builtin_amdgcn_permlane32_swap(__float_as_uint(l_reg), __float_as_uint(l_reg), false, false); l_reg = __uint_as_float(rr[0]) + __uint_as_float(rr[1]); }
    { int le_ = threadIdx.x & 63; asm volatile("" : "+v"(le_)); const int lane = le_, r32 = lane & 31, hi = lane >> 5;
    if (hi == 0) wsf[32 + r32] = l_reg; asm volatile("s_waitcnt lgkmcnt(0)" ::: "memory");
    float rli[16];
#pragma unroll
    for (int r = 0; r < 16; ++r) rli[r] = __builtin_amdgcn_rcpf(wsf[32 + crow(r, hi)]);
    h16* Ow = O + (rowbase + q0 + wid * QBLK) * PO + h * D;
    { h16* stg = (h16*)(shm + LDS_OST) + wid * 2048;
#pragma unroll
      for (int r = 0; r < 16; ++r) { const int orow = crow(r, hi);
#pragma unroll
          for (int d0 = 0; d0 < 2; ++d0) stg[orow * 64 + d0 * 32 + r32] = f2h(o[d0][r] * rli[r]); }
      asm volatile("s_waitcnt lgkmcnt(0)" ::: "memory");
#pragma unroll
      for (int i = 0; i < 4; ++i) { const int row = i * 8 + (lane >> 3), ch = lane & 7; const u32x4 v = *(const u32x4*)(stg + row * 64 + ch * 8); *(GAS u32x4*)((GAS char*)Ow + (unsigned)(row * PO + ch * 8) * 2u) = v; } } }
    asm volatile("s_waitcnt lgkmcnt(0)\n\ts_barrier" ::: "memory");
#undef DMA_K
#undef DMA_V
#undef MROW
#undef BIASB
#undef START
#undef RESC
#undef ROT
}
#undef SBAR
#undef WAIT_BAR
#undef MFQK
#undef MFPV
#undef MSK
#undef BP
}
static_assert(attn_body::LDS_BYTES <= WORK_BYTES, "attention LDS");

constexpr int LDP = 136;
constexpr int RT_BYTES = 128 * LDP * 2;
static_assert(4 * RT_BYTES <= WORK_BYTES, "retention LDS");
__device__ __forceinline__ void mm128(const LAS h16* A, const LAS h16* Bt, int wave, int lane, f32x4 (&acc)[8]) {
    const int r = lane & 15, q = lane >> 4;
#pragma unroll
    for (int ks = 0; ks < 4; ++ks) {
        const f16x8 av = __builtin_bit_cast(f16x8, *(const LAS s16x8*)(A + (16 * wave + r) * LDP + ks * 32 + q * 8));
#pragma unroll
        for (int nt = 0; nt < 8; ++nt) { const f16x8 bv = __builtin_bit_cast(f16x8, *(const LAS s16x8*)(Bt + (16 * nt + r) * LDP + ks * 32 + q * 8));
            acc[nt] = __builtin_amdgcn_mfma_f32_16x16x32_f16(av, bv, acc[nt], 0, 0, 0); }
    }
}
__device__ __forceinline__ float gamma_log2(int h) { return log2f(1.0f - exp2f(-5.0f - (float)h)); }
template <bool TRANS>
__device__ __forceinline__ void load_rot(const Frame& F, const h16* src  , const f32x2* rot  , LAS h16* dst, float scale, float lg2, int decay_mode  ) {
    for (int e = F.tid; e < 128 * 64; e += NTHR) { const int j = e >> 6, i = e & 63;
        const float x1 = h2f(src[(size_t)j * 512 + i]), x2 = h2f(src[(size_t)j * 512 + 64 + i]); const f32x2 cs = rot[j * 64 + i];
        float sc = scale; if (decay_mode == 1) sc *= exp2f((float)(127 - j) * lg2);
        const float o1 = (x1 * cs[0] - x2 * cs[1]) * sc, o2 = (x1 * cs[1] + x2 * cs[0]) * sc;
        if (TRANS) { dst[i * LDP + j] = f2h(o1); dst[(64 + i) * LDP + j] = f2h(o2); } else { dst[j * LDP + i] = f2h(o1); dst[j * LDP + 64 + i] = f2h(o2); } }
}
__device__ __forceinline__ void ret_kv_unit(const Frame& F, const Args& a, int unit) {
    unsigned char* ws = a.ws; const int c = unit & 31, h = (unit >> 5) & 3, b = unit >> 7;
    LAS h16* Kt = (LAS h16*)(F.lds); LAS h16* Vt = (LAS h16*)(F.lds + RT_BYTES);
    const size_t row0 = (size_t)b * SEQ + c * 128; const float lg2 = gamma_log2(h);
    load_rot<true>(F, (const h16*)(ws + WS_KR) + row0 * 512 + h * 128, (const f32x2*)(ws + WS_ROT) + (size_t)(c * 128) * 64, Kt, 0.08838834764831845f, lg2, 1);
    const h16* V = (const h16*)(ws + WS_VR) + row0 * 512 + h * 128;
    for (int e = F.tid; e < 128 * 128; e += NTHR) { const int j = e >> 7, d = e & 127; Vt[d * LDP + j] = V[(size_t)j * 512 + d]; }
    __syncthreads();
    f32x4 acc[8];
#pragma unroll
    for (int i = 0; i < 8; ++i) acc[i] = (f32x4){0.f, 0.f, 0.f, 0.f};
    mm128(Kt, Vt, F.wave, F.lane, acc);
    float* KVC = (float*)(ws + WS_KVC) + (size_t)unit * 16384; const int r = F.lane & 15, q = F.lane >> 4;
#pragma unroll
    for (int nt = 0; nt < 8; ++nt)
#pragma unroll
        for (int g = 0; g < 4; ++g) KVC[(16 * F.wave + 4 * q + g) * 128 + 16 * nt + r] = acc[nt][g];
    __syncthreads();
}
__device__ __forceinline__ void ret_scan(const Frame& F, const Args& a) {
    unsigned char* ws = a.ws; const float* KVC = (const float*)(ws + WS_KVC); float* SC = (float*)(ws + WS_SC);
    for (int e = F.vcu * NTHR + F.tid; e < NB * HR * 16384; e += F.G * NTHR) {
        const int bh = e >> 14, el = e & 16383, h = bh & 3; const float cd = exp2f(128.0f * gamma_log2(h));
        float kv[32];
#pragma unroll
        for (int c = 0; c < 32; ++c) kv[c] = KVC[((size_t)bh * 32 + c) * 16384 + el];
        float s = 0.f;
#pragma unroll
        for (int c = 0; c < 32; ++c) { SC[((size_t)bh * 32 + c) * 16384 + el] = s; s = cd * s + kv[c]; }
        a.out[O_RSP + (size_t)bh * 16384 + el] = s;
    }
}
__device__ __forceinline__ void ret_out_unit(const Frame& F, const Args& a, int unit) {
    unsigned char* ws = a.ws; const int c = unit & 31, h = (unit >> 5) & 3, b = unit >> 7;
    LAS h16* Qs = (LAS h16*)(F.lds); LAS h16* Ks = (LAS h16*)(F.lds + RT_BYTES); LAS h16* Vt = (LAS h16*)(F.lds + 2 * RT_BYTES); LAS h16* St = (LAS h16*)(F.lds + 3 * RT_BYTES);
    const size_t row0 = (size_t)b * SEQ + c * 128; const float lg2 = gamma_log2(h);
    const f32x2* rot = (const f32x2*)(ws + WS_ROT) + (size_t)(c * 128) * 64;
    load_rot<false>(F, (const h16*)(ws + WS_QR) + row0 * 512 + h * 128, rot, Qs, 1.0f, lg2, 0);
    load_rot<false>(F, (const h16*)(ws + WS_KR) + row0 * 512 + h * 128, rot, Ks, 0.08838834764831845f, lg2, 0);
    const h16* V = (const h16*)(ws + WS_VR) + row0 * 512 + h * 128;
    for (int e = F.tid; e < 128 * 128; e += NTHR) { const int j = e >> 7, d = e & 127; Vt[d * LDP + j] = V[(size_t)j * 512 + d]; }
    const float* S = (const float*)(ws + WS_SC) + (size_t)unit * 16384;
    for (int e = F.tid; e < 128 * 128; e += NTHR) { const int dk = e >> 7, dv = e & 127; St[dv * LDP + dk] = f2h(S[e]); }
    __syncthreads();
    const int r = F.lane & 15, q = F.lane >> 4;
    f32x4 acc[8];
#pragma unroll
    for (int i = 0; i < 8; ++i) acc[i] = (f32x4){0.f, 0.f, 0.f, 0.f};
    mm128(Qs, Ks, F.wave, F.lane, acc);
    __syncthreads();
#pragma unroll
    for (int nt = 0; nt < 8; ++nt)
#pragma unroll
        for (int g = 0; g < 4; ++g) { const int i = 16 * F.wave + 4 * q + g, j = 16 * nt + r; const float v = (i >= j) ? acc[nt][g] * exp2f((float)(i - j) * lg2) : 0.f; Ks[i * LDP + j] = f2h(v); }
    __syncthreads();
    f32x4 o1[8], o2[8];
#pragma unroll
    for (int i = 0; i < 8; ++i) { o1[i] = (f32x4){0.f, 0.f, 0.f, 0.f}; o2[i] = (f32x4){0.f, 0.f, 0.f, 0.f}; }
    mm128(Ks, Vt, F.wave, F.lane, o1);
    mm128(Qs, St, F.wave, F.lane, o2);
    const float* gng = a.in[14] + h * 128; const h16* GR = (const h16*)(ws + WS_GR); h16* MIX = (h16*)(ws + WS_MIX);
#pragma unroll
    for (int g = 0; g < 4; ++g) { const int i = 16 * F.wave + 4 * q + g; const float cross = exp2f((float)(i + 1) * lg2);
        float v[8]; float s = 0.f;
#pragma unroll
        for (int nt = 0; nt < 8; ++nt) { v[nt] = o1[nt][g] + cross * o2[nt][g]; s += v[nt]; }
        s += __shfl_xor(s, 1); s += __shfl_xor(s, 2); s += __shfl_xor(s, 4); s += __shfl_xor(s, 8);
        const float mu = s * (1.f / 128.f); float s2 = 0.f;
#pragma unroll
        for (int nt = 0; nt < 8; ++nt) { v[nt] -= mu; s2 += v[nt] * v[nt]; }
        s2 += __shfl_xor(s2, 1); s2 += __shfl_xor(s2, 2); s2 += __shfl_xor(s2, 4); s2 += __shfl_xor(s2, 8);
        const float rstd = 1.f / sqrtf(s2 * (1.f / 128.f) + GN_EPS);
        const size_t row = row0 + i;
#pragma unroll
        for (int nt = 0; nt < 8; ++nt) { const int dv = 16 * nt + r; const float gt = h2f(GR[row * 512 + h * 128 + dv]);
            MIX[row * DM + 512 + h * 128 + dv] = f2h(v[nt] * rstd * gng[dv] * silu_f(gt)); } }
    __syncthreads();
}
__device__ __forceinline__ void ret_sample_unit(const Frame& F, const Args& a, int unit) {
    unsigned char* ws = a.ws; const int h = unit & 3, b = unit >> 2; const int row = MP + b;
    LAS float* qs = (LAS float*)(F.lds); LAS float* ks = qs + 128; LAS float* part = ks + 128; LAS float* red = part + 512;
    const float lg2 = gamma_log2(h); const float gam = exp2f(lg2);
    const f32x2* rot = (const f32x2*)(ws + WS_ROT) + (size_t)4096 * 64;
    if (F.tid < 128) { const int i = F.tid & 63; const bool second = F.tid >= 64;
        const h16* src = (const h16*)(ws + (F.tid < 128 ? WS_QR : WS_KR)) + (size_t)row * 512 + h * 128;
        const float x1 = h2f(src[i]), x2 = h2f(src[64 + i]); const f32x2 cs = rot[i];
        qs[F.tid] = second ? (x1 * cs[1] + x2 * cs[0]) : (x1 * cs[0] - x2 * cs[1]);
    } else if (F.tid < 256) { const int tt = F.tid - 128; const int i = tt & 63; const bool second = tt >= 64;
        const h16* src = (const h16*)(ws + WS_KR) + (size_t)row * 512 + h * 128;
        const float x1 = h2f(src[i]), x2 = h2f(src[64 + i]); const f32x2 cs = rot[i];
        ks[tt] = (second ? (x1 * cs[1] + x2 * cs[0]) : (x1 * cs[0] - x2 * cs[1])) * 0.08838834764831845f;
    }
    __syncthreads();
    const int dv = F.tid & 127, qd = F.tid >> 7;
    const float v = h2f(((const h16*)(ws + WS_VR))[(size_t)row * 512 + h * 128 + dv]);
    const float* S0 = a.in[5] + ((size_t)b * HR + h) * 16384; float* SN = a.out + O_RSS + ((size_t)b * HR + h) * 16384;
    float po = 0.f, qk = 0.f;
    for (int dk = 32 * qd; dk < 32 * qd + 32; ++dk) { const float s0 = S0[dk * 128 + dv]; po += qs[dk] * s0; SN[dk * 128 + dv] = gam * s0 + ks[dk] * v; qk += qs[dk] * ks[dk]; }
    part[qd * 128 + dv] = po; if (dv == 0) red[qd] = qk;
    __syncthreads();
    if (F.tid < 128) {
        const float qkt = red[0] + red[1] + red[2] + red[3];
        float o = qkt * v + gam * (part[dv] + part[128 + dv] + part[256 + dv] + part[384 + dv]);
        float s = wave_sum(o); if (F.lane == 0) red[8 + F.wave] = s;
        asm volatile("s_waitcnt lgkmcnt(0)" ::: "memory");
        part[dv] = o;
    }
    __syncthreads();
    if (F.tid < 128) {
        const float mu = (red[8] + red[9]) * (1.f / 128.f); const float o = part[dv] - mu;
        float s2 = wave_sum(o * o); if (F.lane == 0) red[12 + F.wave] = s2;
    }
    __syncthreads();
    if (F.tid < 128) {
        const float mu = (red[8] + red[9]) * (1.f / 128.f); const float o = part[dv] - mu;
        const float rstd = 1.f / sqrtf((red[12] + red[13]) * (1.f / 128.f) + GN_EPS);
        const float gt = h2f(((const h16*)(ws + WS_GR))[(size_t)row * 512 + h * 128 + dv]);
        ((h16*)(ws + WS_MIX))[(size_t)row * DM + 512 + h * 128 + dv] = f2h(o * rstd * a.in[14][h * 128 + dv] * silu_f(gt));
    }
    __syncthreads();
}

constexpr int N_PHASES = 13;
__global__ void __launch_bounds__(NTHR, 2) skel_fwd(Args args) {
    extern __shared__ __attribute__((aligned(16))) unsigned char lds[];
    Frame F;
    F.lds = (LAS unsigned char*)lds;
    F.tid = threadIdx.x; F.lane = F.tid & 63; F.wave = __builtin_amdgcn_readfirstlane(F.tid >> 6);
    F.G = gridDim.x; { const int bx = blockIdx.x; F.vcu = (F.G % 8 == 0) ? (bx % 8) * (F.G / 8) + bx / 8 : bx; }
    unsigned char* ws = args.ws;
    const int lo = args.ph_lo, hi = args.ph_hi;
    for (int u = F.tid; u < (LDS_BYTES - LDSCTL_OFF) / 4; u += NTHR) ((LAS unsigned*)(F.lds + LDSCTL_OFF))[u] = 0u;
    __syncthreads();
    XcdBarrier bar = xcd_barrier_post((unsigned*)(ws + WS_CTL) + CW_BAR, (volatile LAS unsigned*)(F.lds + MISC_OFF) + 8);
#define IN(k) (lo <= (k) && (k) < hi)
#define GRID_BAR(k) do { if (IN(k) && IN((k) + 1)) xcd_barrier(bar); } while (0)
    if (IN(0)) { p0_prologue(F, args); }
    GRID_BAR(0);
    if (IN(1)) {
        pg8::Gemm g{(const h16*)(ws + WS_X16), (const h16*)(ws + WS_WGU1), MR, 2 * DFF, DM}; pg8::StaticOrder S; S.init(MR, 2 * DFF, F.G, (int)blockIdx.x);
        pg8::EpiSwiglu E{(h16*)(ws + WS_H1), DFF};
        pg8::gemm_phase<pg8::EpiSwiglu, pg8::StaticOrder, true>(F.lds, g, S, E);
    }
    GRID_BAR(1);
    if (IN(2)) {
        pg8::Gemm g{(const h16*)(ws + WS_H1), (const h16*)(ws + WS_WD1), MR, DM, DFF}; pg8::StaticOrder S; S.init(MR, DM, F.G, (int)blockIdx.x);
        pg8::EpiResid E{(const float*)(ws + WS_HF), (float*)(ws + WS_V), DM, ALPHA, 0.5f};
        pg8::gemm_phase<pg8::EpiResid, pg8::StaticOrder, true>(F.lds, g, S, E);
    }
    GRID_BAR(2);
    if (IN(3)) { ln_rows(F, (const float*)(ws + WS_V), args.in[11], args.in[12], (float*)(ws + WS_HF), (h16*)(ws + WS_H16), MV); }
    GRID_BAR(3);
    if (IN(4)) {
        pg8::Gemm g{(const h16*)(ws + WS_H16), (const h16*)(ws + WS_WIN), MR, NINP, DM}; pg8::StaticOrder S; S.init(MR, NINP, F.G, (int)blockIdx.x);
        pg8::EpiWin E; E.p16base = (h16*)(ws + WS_QA); E.p16stride = SZ_P16 / 2;
        E.ki16 = (h16*)(ws + WS_KI); E.wi = (float*)(ws + WS_WI); E.dout = args.out;
        pg8::gemm_phase<pg8::EpiWin, pg8::StaticOrder, true>(F.lds, g, S, E);
    }
    GRID_BAR(4);
    if (IN(5)) {
        for (int u = F.vcu; u < NS * 8; u += F.G) sample_score_unit(F, args, u);
        for (int p = F.vcu; p < 256; p += F.G) { const int b = p >> 6, sx = p & 63; idx_unit(F, args, b, sx); idx_unit(F, args, b, 127 - sx); }
        xcd_barrier(bar);
        for (int u = F.vcu; u < NB * HR * 32; u += F.G) ret_kv_unit(F, args, u);
        for (int u = F.vcu; u < NS * 8; u += F.G) sample_attn_unit(F, args, u);
        for (int p = F.vcu; p < 256; p += F.G) { const int bh = p >> 3, sx = p & 7;
            for (int i = 0; i < 2; ++i) attn_body::attn_unit<8>(bh >> 3, bh & 7, i == 0 ? sx : 15 - sx, (const h16*)(ws + WS_QA), (const h16*)(ws + WS_KA), (const h16*)(ws + WS_VA), (h16*)(ws + WS_MIX),
                                                              (const unsigned long long*)(ws + WS_MASK), args.in[7], (char*)lds); }
    }
    GRID_BAR(5);
    if (IN(6)) { ret_scan(F, args); for (int u = F.vcu; u < NS * HR; u += F.G) ret_sample_unit(F, args, u); }
    GRID_BAR(6);
    if (IN(7)) { for (int u = F.vcu; u < NB * HR * 32; u += F.G) ret_out_unit(F, args, u); }
    GRID_BAR(7);
    if (IN(8)) {
        pg8::Gemm g{(const h16*)(ws + WS_MIX), (const h16*)(ws + WS_WOUT), MR, DM, DM}; pg8::StaticOrder S; S.init(MR, DM, F.G, (int)blockIdx.x);
        pg8::EpiResid E{(const float*)(ws + WS_HF), (float*)(ws + WS_V), DM, ALPHA, 1.0f};
        pg8::gemm_phase<pg8::EpiResid, pg8::StaticOrder, true>(F.lds, g, S, E);
    }
    GRID_BAR(8);
    if (IN(9)) { ln_rows(F, (const float*)(ws + WS_V), args.in[16], args.in[17], (float*)(ws + WS_HF), (h16*)(ws + WS_H16), MV); }
    GRID_BAR(9);
    if (IN(10)) {
        pg8::Gemm g{(const h16*)(ws + WS_H16), (const h16*)(ws + WS_WGU2), MR, 2 * DFF, DM}; pg8::StaticOrder S; S.init(MR, 2 * DFF, F.G, (int)blockIdx.x);
        pg8::EpiSwiglu E{(h16*)(ws + WS_H1), DFF};
        pg8::gemm_phase<pg8::EpiSwiglu, pg8::StaticOrder, true>(F.lds, g, S, E);
    }
    GRID_BAR(10);
    if (IN(11)) {
        pg8::Gemm g{(const h16*)(ws + WS_H1), (const h16*)(ws + WS_WD2), MR, DM, DFF}; pg8::StaticOrder S; S.init(MR, DM, F.G, (int)blockIdx.x);
        pg8::EpiResid E{(const float*)(ws + WS_HF), (float*)(ws + WS_V), DM, ALPHA, 0.5f};
        pg8::gemm_phase<pg8::EpiResid, pg8::StaticOrder, true>(F.lds, g, S, E);
    }
    GRID_BAR(11);
    if (IN(12)) { ln_rows(F, (const float*)(ws + WS_V), args.in[21], args.in[22], args.out + O_Y, nullptr, MV); }
#undef IN
#undef GRID_BAR
}

extern "C" void kernel_launch(void* const* d_in, const int* in_sizes, int n_in, void* d_out, int out_size, void* d_ws, size_t ws_size, hipStream_t stream) {
    static int grid = 0;
    if (grid == 0) {
        if (n_in != 23 || out_size != (int)O_END || ws_size < WS_END) { fprintf(stderr, "kernel_launch: unexpected sizes (n_in %d out %d ws %zu need %zu)\n", n_in, out_size, ws_size, (size_t)WS_END); grid = -1; return; }
        int dev = 0, cus = 0;
        if (hipGetDevice(&dev) != hipSuccess || hipDeviceGetAttribute(&cus, hipDeviceAttributeMultiprocessorCount, dev) != hipSuccess) { grid = -1; return; }
        if (hipFuncSetAttribute((const void*)skel_fwd, hipFuncAttributeMaxDynamicSharedMemorySize, LDS_BYTES) != hipSuccess) { fprintf(stderr, "kernel_launch: hipFuncSetAttribute failed\n"); grid = -1; return; }
        (void)hipGetLastError();
        grid = cus;
    }
    if (grid < 0) return;
    Args a{};
    for (int i = 0; i < 23; ++i) a.in[i] = (const float*)d_in[i];
    a.page_table = (const int*)d_in[6];
    a.out = (float*)d_out; a.ws = (unsigned char*)d_ws;
    if (hipMemsetAsync((char*)d_ws + WS_CTL, 0, CTL_ZERO_BYTES, stream) != hipSuccess) { fprintf(stderr, "kernel_launch: memset failed\n"); return; }
    a.ph_lo = 0; a.ph_hi = N_PHASES;
    hipLaunchKernelGGL(skel_fwd, dim3(grid), dim3(NTHR), LDS_BYTES, stream, a);
}
```
